# Optimizing an MI355X kernel written in HIP

```python
import math
import jax, jax.numpy as jnp
from jax import lax
import numpy as np

D_MODEL = 2048
BATCH = 8
SEQ = 4096
DEPTH = 4
DEC_BATCH = 8
DEC_SEQ = 16
PAST_LEN = 4096

CHUNK = 64
N_MIXERS = 3
N_A = (DEPTH + 2) // 3
N_B = (DEPTH + 1) // 3
N_C = DEPTH // 3
A_HEADS = 4
A_DV = D_MODEL // A_HEADS
A_DQK = A_DV // 2
A_IN = 2 * A_HEADS * A_DQK + 2 * A_HEADS * A_DV + 2 * A_HEADS
CONV_W = 3
S5_P = 16
S5_G = D_MODEL // S5_P
S5_N = 64
D_FF = -(-8 * D_MODEL // (3 * 256)) * 256
EPS = 1e-6

kernel_name = "hybrid_streaming_encoder_step"


def rmsnorm(x, g):
    xf = x.astype(jnp.float32)
    y = xf * lax.rsqrt(jnp.mean(xf * xf, axis=-1, keepdims=True) + EPS)
    return (y * g.astype(jnp.float32)).astype(x.dtype)


def to_chunks(a, lc):
    b, l = a.shape[0], a.shape[1]
    return jnp.moveaxis(a.reshape((b, l // lc, lc) + a.shape[2:]), 1, 0)


def from_chunks(a):
    a = jnp.moveaxis(a, 0, 1)
    return a.reshape((a.shape[0], a.shape[1] * a.shape[2]) + a.shape[3:])


def mlstm_chunk(carry, inp):
    C, n, m = carry
    q, k, v, li, lf = inp
    L = q.shape[1]
    b = jnp.swapaxes(jnp.cumsum(lf, axis=1), 1, 2)
    li = jnp.swapaxes(li, 1, 2)
    causal = jnp.arange(L)[:, None] >= jnp.arange(L)[None, :]
    dmat = jnp.where(causal, b[..., :, None] - b[..., None, :] + li[..., None, :], -jnp.inf)
    inter = b + m[..., None]
    m_t = jnp.maximum(inter, jnp.max(dmat, axis=-1))
    w = jnp.exp(dmat - m_t[..., None])
    s = jnp.einsum('blhd,bshd->bhls', q, k) * w
    inter_w = jnp.exp(inter - m_t)
    num = jnp.einsum('bhls,bshv->blhv', s, v) + jnp.einsum('bhl,blhd,bhdv->blhv', inter_w, q, C)
    den = jnp.sum(s, axis=-1) + inter_w * jnp.einsum('blhd,bhd->bhl', q, n)
    floor = jnp.maximum(jnp.abs(den), jnp.exp(-m_t))
    h = num / jnp.swapaxes(floor, 1, 2)[..., None]
    m_new = m_t[..., -1]
    w_last = w[..., -1, :]
    decay = inter_w[..., -1]
    C_new = decay[..., None, None] * C + jnp.einsum('bhs,bshd,bshv->bhdv', w_last, k, v)
    n_new = decay[..., None] * n + jnp.einsum('bhs,bshd->bhd', w_last, k)
    return (C_new, n_new, m_new), h


def mlstm_mixer(h, w_in, b_gates, g_hnorm, w_out, C0, n0, m0):
    f32 = jnp.float32
    bsz, L, _ = h.shape
    hk, hv = A_HEADS * A_DQK, A_HEADS * A_DV
    z = h @ w_in
    q, k, v, o, gates = jnp.split(z, [hk, 2 * hk, 2 * hk + hv, 2 * hk + 2 * hv], axis=-1)
    q = q.reshape(bsz, L, A_HEADS, A_DQK).astype(f32) * (A_DQK ** -0.5)
    k = k.reshape(bsz, L, A_HEADS, A_DQK).astype(f32)
    v = v.reshape(bsz, L, A_HEADS, A_DV).astype(f32)
    gates = gates.astype(f32) + b_gates.astype(f32)
    li = gates[..., :A_HEADS]
    lf = jax.nn.log_sigmoid(gates[..., A_HEADS:])
    lc = min(CHUNK, L)
    (C, n, m), hs = lax.scan(
        mlstm_chunk, (C0.astype(f32), n0.astype(f32), m0.astype(f32)),
        (to_chunks(q, lc), to_chunks(k, lc), to_chunks(v, lc), to_chunks(li, lc), to_chunks(lf, lc)))
    hs = rmsnorm(from_chunks(hs), g_hnorm.reshape(A_HEADS, A_DV))
    y = (hs.reshape(bsz, L, hv) * jax.nn.sigmoid(o.astype(f32))).astype(h.dtype) @ w_out
    return y, C.astype(C0.dtype), n.astype(n0.dtype), m.astype(m0.dtype)


def conv_mixer(h, w_in, w_conv, w_out, prev):
    L = h.shape[1]
    gb, gc, u = jnp.split(h @ w_in, 3, axis=-1)
    z = gc * u
    zp = jnp.concatenate([prev.astype(z.dtype), z], axis=1)
    conv = (zp[:, 0:L] * w_conv[:, 0] + zp[:, 1:L + 1] * w_conv[:, 1]
            + zp[:, 2:L + 2] * w_conv[:, 2])
    y = (gb * conv) @ w_out
    return y, zp[:, -(CONV_W - 1):].astype(prev.dtype)


def _cscan_combine(e1, e2):
    a1r, a1i, b1r, b1i = e1
    a2r, a2i, b2r, b2i = e2
    return (a1r * a2r - a1i * a2i, a1r * a2i + a1i * a2r,
            a2r * b1r - a2i * b1i + b2r, a2r * b1i + a2i * b1r + b2i)


def s5_mixer(h, a_re, a_im, b_re, b_im, c_re, c_im, d_skip, log_dt, w_out, s_re0, s_im0):
    f32 = jnp.float32
    bsz, L, _ = h.shape
    u = h.astype(f32).reshape(bsz, L, S5_G, S5_P)
    dt = jnp.exp(log_dt.astype(f32))[:, None]
    lr, lim = a_re.astype(f32), a_im.astype(f32)
    mag = jnp.exp(lr * dt)
    ab_re, ab_im = mag * jnp.cos(lim * dt), mag * jnp.sin(lim * dt)
    den = lr * lr + lim * lim
    nr = ab_re - 1.0
    fr = (nr * lr + ab_im * lim) / den
    fi = (ab_im * lr - nr * lim) / den
    br, bi = b_re.astype(f32), b_im.astype(f32)
    bb_re = fr[..., None] * br - fi[..., None] * bi
    bb_im = fr[..., None] * bi + fi[..., None] * br
    cr, ci = c_re.astype(f32), c_im.astype(f32)
    dsk = d_skip.astype(f32)

    def chunk_step(carry, uc):
        x_re, x_im = carry
        bu_re = jnp.einsum('blgp,gnp->blgn', uc, bb_re)
        bu_im = jnp.einsum('blgp,gnp->blgn', uc, bb_im)
        ar = jnp.broadcast_to(ab_re, bu_re.shape)
        ai = jnp.broadcast_to(ab_im, bu_re.shape)
        pa_re, pa_im, pb_re, pb_im = lax.associative_scan(
            _cscan_combine, (ar, ai, bu_re, bu_im), axis=1)
        st_re = pb_re + pa_re * x_re[:, None] - pa_im * x_im[:, None]
        st_im = pb_im + pa_re * x_im[:, None] + pa_im * x_re[:, None]
        y = (jnp.einsum('blgn,gpn->blgp', st_re, cr) - jnp.einsum('blgn,gpn->blgp', st_im, ci)
             + dsk * uc)
        return (st_re[:, -1], st_im[:, -1]), y

    lc = min(CHUNK, L)
    (s_re, s_im), ys = lax.scan(chunk_step, (s_re0.astype(f32), s_im0.astype(f32)), to_chunks(u, lc))
    y = jax.nn.gelu(from_chunks(ys).reshape(bsz, L, D_MODEL)).astype(h.dtype)
    za, zb = jnp.split(y @ w_out, 2, axis=-1)
    return za * jax.nn.sigmoid(zb), s_re.astype(s_re0.dtype), s_im.astype(s_im0.dtype)


def swiglu(h, wg, wu, wd):
    return (jax.nn.silu(h @ wg) * (h @ wu)) @ wd


def _trunk(x, c, st_C, st_n, st_m, st_conv, st_re, st_im, p):
    bsz = x.shape[0]
    sc = jax.nn.silu(c)
    new_C, new_n, new_m, new_conv, new_re, new_im = [], [], [], [], [], []
    for i in range(DEPTH):
        mod = (sc @ p['w_mod'][i] + p['b_mod'][i]).reshape(bsz, 6, 1, D_MODEL)
        sh1, sc1, g1, sh2, sc2, g2 = (mod[:, j] for j in range(6))
        gn = p['g_norm'][i]
        h = rmsnorm(x, gn[0]) * (1 + sc1) + sh1
        kind, j = i % N_MIXERS, i // N_MIXERS
        if kind == 0:
            out, C, n, m = mlstm_mixer(h, p['wA_in'][j], p['bA_gates'][j], p['gA_hnorm'][j],
                                       p['wA_out'][j], st_C[j], st_n[j], st_m[j])
            new_C.append(C); new_n.append(n); new_m.append(m)
        elif kind == 1:
            out, cv = conv_mixer(h, p['wB_in'][j], p['wB_conv'][j], p['wB_out'][j], st_conv[j])
            new_conv.append(cv)
        else:
            out, sr, si = s5_mixer(h, p['s5_A_re'][j], p['s5_A_im'][j], p['s5_B_re'][j],
                                   p['s5_B_im'][j], p['s5_C_re'][j], p['s5_C_im'][j],
                                   p['s5_D'][j], p['s5_log_dt'][j], p['wC_out'][j],
                                   st_re[j], st_im[j])
            new_re.append(sr); new_im.append(si)
        x = x + g1 * rmsnorm(out, gn[1])
        h = rmsnorm(x, gn[2]) * (1 + sc2) + sh2
        x = x + g2 * rmsnorm(swiglu(h, p['w_ffn_gate'][i], p['w_ffn_up'][i], p['w_ffn_down'][i]), gn[3])
    return (x, jnp.stack(new_C), jnp.stack(new_n), jnp.stack(new_m), jnp.stack(new_conv),
            jnp.stack(new_re), jnp.stack(new_im))


def setup_inputs(seed: int = 0) -> dict:
    key = jax.random.key(seed)
    ks = jax.random.split(key, 40)
    nrm = jax.random.normal
    D, F, f32 = D_MODEL, D_FF, jnp.float32
    f_bias = jnp.linspace(3.0, 6.0, A_HEADS)
    bA = jnp.concatenate([0.1 * nrm(ks[13], (N_A, A_HEADS)),
                          f_bias + 0.1 * nrm(ks[14], (N_A, A_HEADS))], axis=-1)
    return {
        "x_prompt": nrm(ks[0], (BATCH, SEQ, D), f32),
        "x_sample": nrm(ks[1], (DEC_BATCH, DEC_SEQ, D), f32),
        "state_mlstm_C": 0.3 * nrm(ks[2], (N_A, DEC_BATCH, A_HEADS, A_DQK, A_DV), f32),
        "state_mlstm_n": 0.3 * nrm(ks[3], (N_A, DEC_BATCH, A_HEADS, A_DQK), f32),
        "state_mlstm_m": 2.0 + 0.5 * nrm(ks[4], (N_A, DEC_BATCH, A_HEADS), f32),
        "state_conv": nrm(ks[5], (N_B, DEC_BATCH, CONV_W - 1, D), f32),
        "state_s5_re": 0.1 * nrm(ks[6], (N_C, DEC_BATCH, S5_G, S5_N), f32),
        "state_s5_im": 0.1 * nrm(ks[7], (N_C, DEC_BATCH, S5_G, S5_N), f32),
        "c_prompt": nrm(ks[8], (BATCH, D), f32),
        "c_sample": nrm(ks[9], (DEC_BATCH, D), f32),
        "w_mod": 0.5 * D ** -0.5 * nrm(ks[10], (DEPTH, D, 6 * D), f32),
        "b_mod": 0.02 * nrm(ks[11], (DEPTH, 6 * D), f32),
        "g_norm": 1.0 + 0.02 * nrm(ks[12], (DEPTH, 4, D), f32),
        "wA_in": D ** -0.5 * nrm(ks[15], (N_A, D, A_IN), f32),
        "bA_gates": bA.astype(f32),
        "gA_hnorm": 1.0 + 0.02 * nrm(ks[16], (N_A, A_HEADS * A_DV), f32),
        "wA_out": (A_HEADS * A_DV) ** -0.5 * nrm(ks[17], (N_A, A_HEADS * A_DV, D), f32),
        "wB_in": D ** -0.5 * nrm(ks[18], (N_B, D, 3 * D), f32),
        "wB_conv": CONV_W ** -0.5 * nrm(ks[19], (N_B, D, CONV_W), f32),
        "wB_out": D ** -0.5 * nrm(ks[20], (N_B, D, D), f32),
        "s5_A_re": -0.5 + 0.01 * nrm(ks[21], (N_C, S5_G, S5_N), f32),
        "s5_A_im": jnp.pi * jnp.arange(S5_N, dtype=f32) + 0.01 * nrm(ks[22], (N_C, S5_G, S5_N), f32),
        "s5_B_re": (2 * S5_P) ** -0.5 * nrm(ks[23], (N_C, S5_G, S5_N, S5_P), f32),
        "s5_B_im": (2 * S5_P) ** -0.5 * nrm(ks[24], (N_C, S5_G, S5_N, S5_P), f32),
        "s5_C_re": (2 * S5_N) ** -0.5 * nrm(ks[25], (N_C, S5_G, S5_P, S5_N), f32),
        "s5_C_im": (2 * S5_N) ** -0.5 * nrm(ks[26], (N_C, S5_G, S5_P, S5_N), f32),
        "s5_D": nrm(ks[27], (N_C, S5_G, S5_P), f32),
        "s5_log_dt": jax.random.uniform(ks[28], (N_C, S5_G), f32, math.log(1e-3), math.log(1e-1)),
        "wC_out": D ** -0.5 * nrm(ks[29], (N_C, D, 2 * D), f32),
        "w_ffn_gate": D ** -0.5 * nrm(ks[30], (DEPTH, D, F), f32),
        "w_ffn_up": D ** -0.5 * nrm(ks[31], (DEPTH, D, F), f32),
        "w_ffn_down": F ** -0.5 * nrm(ks[32], (DEPTH, F, D), f32),
    }


def reference(x_prompt, x_sample, state_mlstm_C, state_mlstm_n, state_mlstm_m, state_conv,
              state_s5_re, state_s5_im, c_prompt, c_sample, w_mod, b_mod, g_norm, wA_in,
              bA_gates, gA_hnorm, wA_out, wB_in, wB_conv, wB_out, s5_A_re, s5_A_im, s5_B_re,
              s5_B_im, s5_C_re, s5_C_im, s5_D, s5_log_dt, wC_out, w_ffn_gate, w_ffn_up,
              w_ffn_down):
    p = dict(w_mod=w_mod, b_mod=b_mod, g_norm=g_norm, wA_in=wA_in, bA_gates=bA_gates,
             gA_hnorm=gA_hnorm, wA_out=wA_out, wB_in=wB_in, wB_conv=wB_conv, wB_out=wB_out,
             s5_A_re=s5_A_re, s5_A_im=s5_A_im, s5_B_re=s5_B_re, s5_B_im=s5_B_im,
             s5_C_re=s5_C_re, s5_C_im=s5_C_im, s5_D=s5_D, s5_log_dt=s5_log_dt, wC_out=wC_out,
             w_ffn_gate=w_ffn_gate, w_ffn_up=w_ffn_up, w_ffn_down=w_ffn_down)
    bp, dt = x_prompt.shape[0], state_mlstm_C.dtype
    z_C = jnp.zeros((N_A, bp, A_HEADS, A_DQK, A_DV), dt)
    z_n = jnp.zeros((N_A, bp, A_HEADS, A_DQK), dt)
    z_m = jnp.zeros((N_A, bp, A_HEADS), dt)
    z_conv = jnp.zeros((N_B, bp, CONV_W - 1, D_MODEL), state_conv.dtype)
    z_re = jnp.zeros((N_C, bp, S5_G, S5_N), state_s5_re.dtype)
    z_im = jnp.zeros((N_C, bp, S5_G, S5_N), state_s5_im.dtype)
    y_prompt, pC, pn, pm, pconv, pre, pim = _trunk(x_prompt, c_prompt, z_C, z_n, z_m, z_conv,
                                                   z_re, z_im, p)
    y_sample, sC, sn, sm, sconv, sre, sim = _trunk(x_sample, c_sample, state_mlstm_C,
                                                   state_mlstm_n, state_mlstm_m, state_conv,
                                                   state_s5_re, state_s5_im, p)
    return (y_prompt, y_sample, pC, pn, pm, pconv, pre, pim, sC, sn, sm, sconv, sre, sim)
```

```cpp
#include <hip/hip_runtime.h>
#include <cstdio>
#include <cstdint>
#include <type_traits>

#ifndef MK_N_LAUNCHES
#define MK_N_LAUNCHES 1
#endif
#ifndef REP_GEMM
#define REP_GEMM 1
#endif
#ifndef REP_MIX
#define REP_MIX 1
#endif

#define LAS __attribute__((address_space(3)))
#define GAS __attribute__((address_space(1)))
typedef unsigned short bf16_t;
typedef short bf16x8 __attribute__((ext_vector_type(8)));
typedef short bf16x4 __attribute__((ext_vector_type(4)));
typedef float f32x4 __attribute__((ext_vector_type(4)));
typedef float f32x2 __attribute__((ext_vector_type(2)));
typedef unsigned u32x4 __attribute__((ext_vector_type(4)));
typedef unsigned u32x2 __attribute__((ext_vector_type(2)));

namespace pg8 {
constexpr int BM = 256, BK = 64, HALF = 128, HTB = HALF * BK * 2, STAGE_BYTES = 8 * HTB, NXCD = 8, WGM = 4;
__host__ __device__ __forceinline__ int lds_byte(int r, int c) { const int st = (r >> 4) * 2 + (c >> 5), rr = r & 15, cc = c & 31, ob = rr * 64 + cc * 2; return st * 1024 + (ob ^ (((ob >> 9) & 1) << 5)); }
__host__ __device__ __forceinline__ void stage_rc(int b, int& R, int& C) { const int st = b / 1024, sb = b % 1024, swz = sb ^ (((sb >> 9) & 1) << 5); R = (st >> 1) * 16 + swz / 64; C = (st & 1) * 32 + (swz % 64) / 2; }
__host__ __device__ __forceinline__ int perm32(int rho) { const int n = rho >> 4, i = rho & 15; return 8 * (i >> 2) + 4 * n + (i & 3); }

struct Unit { int pm, pn; };
struct Gemm { const bf16_t* A; const bf16_t* Bt; };

template <int nM, int nN> struct StaticOrder {
    static constexpr int nwg = nM * nN;
    int G, c;
    __device__ bool next(int i, Unit& u) const {
        const long L = (long)i * G + c; if (L >= nwg) return false;
        int wgid = (int)L; { const int q = nwg / NXCD, r = nwg % NXCD, xcd = wgid % NXCD, off = wgid / NXCD; wgid = (xcd < r ? xcd * (q + 1) : r * (q + 1) + (xcd - r) * q) + off; }
        const int nig = WGM * nN, gid = wgid / nig, fm = gid * WGM, gsz = (nM - fm) < WGM ? (nM - fm) : WGM;
        u.pm = fm + ((wgid % nig) % gsz); u.pn = (wgid % nig) / gsz; return true;
    }
};
struct S5cOrder {
    int G, c;
    __device__ bool next(int i, Unit& u) const { const long L = (long)i * G + c; if (L >= 1024) return false; const int g = (int)L >> 3, r = (int)L & 7; u.pm = g * 4 + (r >> 1); u.pn = g * 2 + (r & 1); return true; }
};
struct S5aOrder {
    int G, c;
    __device__ bool next(int i, Unit& u) const { const long L = (long)i * G + c; if (L >= 512) return false; u.pm = (int)L; u.pn = (int)L >> 2; return true; }
};

typedef __bf16 bf16v2_t __attribute__((ext_vector_type(2)));
__device__ __forceinline__ unsigned cvt_pk_bf16(float lo, float hi) { const f32x2 v = {lo, hi}; const bf16v2_t b = __builtin_convertvector(v, bf16v2_t); return __builtin_bit_cast(unsigned, b); }
__device__ __forceinline__ float fsig(float x) { return __builtin_amdgcn_rcpf(1.0f + __builtin_amdgcn_exp2f(-1.44269504f * x)); }

__device__ __forceinline__ u32x4 lane_xpose(const u32x4 w, const int src4) {
    u32x4 r; r.x = (unsigned)__builtin_amdgcn_ds_bpermute(src4, (int)w.x); r.y = (unsigned)__builtin_amdgcn_ds_bpermute(src4, (int)w.y); r.z = (unsigned)__builtin_amdgcn_ds_bpermute(src4, (int)w.z); r.w = (unsigned)__builtin_amdgcn_ds_bpermute(src4, (int)w.w); return r; }
template <int ldc, int mul_tiles, int act, int plain_coladd> struct EpiGen {
    static constexpr bool PERM = true;
    bf16_t* O;
    __device__ __forceinline__ void operator()(const f32x4 (&acc)[2][2][4][2], const Unit& u, int wr, int wc, int fr0, int fq0) const {
        const int src4 = 4 * ((fr0 & 3) * 16 + 4 * fq0 + (fr0 >> 2));
        const int fr = 4 * fq0 + (fr0 >> 2), fq = fr0 & 3;
        const int row0 = u.pm * BM + wr * 64 + fr;
        if (u.pn < mul_tiles) {
            const int col0 = u.pn * 128 + wc * 32 + 8 * fq;
#pragma unroll
            for (int ai = 0; ai < 2; ++ai)
#pragma unroll
                for (int m = 0; m < 4; ++m) {
                    bf16_t* rowp = O + (size_t)(row0 + ai * HALF + m * 16) * ldc + col0;
                    float v[8];
#pragma unroll
                    for (int n = 0; n < 2; ++n)
#pragma unroll
                        for (int e = 0; e < 4; ++e) {
                            const float a = acc[ai][0][m][n][e], b = acc[ai][1][m][n][e];
                            float r;
                            if (act == 0) r = a * b; else if (act == 1) r = a * fsig(a) * b; else r = a * fsig(b);
                            v[n * 4 + e] = r;
                        }
                    u32x4 w; w.x = cvt_pk_bf16(v[0], v[1]); w.y = cvt_pk_bf16(v[2], v[3]); w.z = cvt_pk_bf16(v[4], v[5]); w.w = cvt_pk_bf16(v[6], v[7]);
                    *(u32x4*)rowp = lane_xpose(w, src4);
                }
        } else {
            const int col0 = u.pn * BM + plain_coladd + wc * 32 + 8 * fq;
#pragma unroll
            for (int ai = 0; ai < 2; ++ai)
#pragma unroll
                for (int m = 0; m < 4; ++m) {
                    bf16_t* rowp = O + (size_t)(row0 + ai * HALF + m * 16) * ldc + col0;
#pragma unroll
                    for (int bj = 0; bj < 2; ++bj) {
                        const f32x4 v0 = acc[ai][bj][m][0], v1 = acc[ai][bj][m][1];
                        u32x4 w; w.x = cvt_pk_bf16(v0[0], v0[1]); w.y = cvt_pk_bf16(v0[2], v0[3]); w.z = cvt_pk_bf16(v1[0], v1[1]); w.w = cvt_pk_bf16(v1[2], v1[3]);
                        *(u32x4*)(rowp + bj * HALF) = lane_xpose(w, src4);
                    }
                }
        }
    }
};
struct EpiS5a {
    static constexpr bool PERM = false;
    float* XL;
    __device__ __forceinline__ void operator()(const f32x4 (&acc)[2][2][4][2], const Unit& u, int wr, int wc, int fr, int fq) const {
        const int row0 = u.pm * BM + wr * 64 + fr, col0 = wc * 32 + 4 * fq;
#pragma unroll
        for (int ai = 0; ai < 2; ++ai)
#pragma unroll
            for (int m = 0; m < 4; ++m) {
                float* rowp = XL + (size_t)(row0 + ai * HALF + m * 16) * 128 + col0;
#pragma unroll
                for (int n = 0; n < 2; ++n) *(f32x4*)(rowp + n * 16) = acc[ai][0][m][n];
            }
    }
};
struct EpiS5c {
    static constexpr bool PERM = true;
    bf16_t* Y;
    __device__ __forceinline__ void operator()(const f32x4 (&acc)[2][2][4][2], const Unit& u, int wr, int wc, int fr, int fq) const {
        const int g = u.pm >> 2, pml = u.pm & 3, pnl = u.pn & 1;
#pragma unroll
        for (int ai = 0; ai < 2; ++ai)
#pragma unroll
            for (int m = 0; m < 4; ++m) {
                const int inst = pml * 256 + ai * HALF + wr * 64 + m * 16 + fr;
                const int b = inst >> 7, c = inst & 127;
#pragma unroll
                for (int bj = 0; bj < 2; ++bj) {
                    const int tc = pnl * 256 + bj * HALF + wc * 32 + 8 * fq;
                    const int t = tc >> 4, p = tc & 15;
                    float v[8];
#pragma unroll
                    for (int n = 0; n < 2; ++n)
#pragma unroll
                        for (int e = 0; e < 4; ++e) {
                            const float x = acc[ai][bj][m][n][e];
                            const float uu = 0.7978845608f * (x + 0.044715f * x * x * x);
                            v[n * 4 + e] = x * fsig(2.0f * uu);
                        }
                    u32x4 w; w.x = cvt_pk_bf16(v[0], v[1]); w.y = cvt_pk_bf16(v[2], v[3]); w.z = cvt_pk_bf16(v[4], v[5]); w.w = cvt_pk_bf16(v[6], v[7]);
                    *(u32x4*)(Y + (size_t)(b * 4096 + c * 32 + t) * 2048 + g * 16 + p) = w;
                }
            }
    }
};

template <int LDA, int LDB, int K, class Epi, class Sched, bool ALIGN_EPI, bool SP2>
__device__ __forceinline__ void gemm_phase(LAS unsigned char* lds, const Gemm g, const Sched& S, const Epi& E, const int tid) {
    const int wid = __builtin_amdgcn_readfirstlane(tid >> 6), lane = tid & 63, wr = wid >> 2, wc = wid & 3, fr = lane & 15, fq = lane >> 4;
    constexpr int nt = K / BK;
    unsigned voffA[2], voffB[2];
#pragma unroll
    for (int i = 0; i < 2; ++i) { int R, C; stage_rc(tid * 16 + i * 8192, R, C); const int Rb = Epi::PERM ? ((R & ~31) + perm32(R & 31)) : R;
        voffA[i] = (unsigned)(R * LDA + C) * 2u; voffB[i] = (unsigned)(Rb * LDB + C) * 2u; }
    constexpr size_t kstep = (size_t)(BK * 2);
    constexpr size_t hstepA = (size_t)HALF * LDA * 2, hstepB = (size_t)HALF * LDB * 2;
    constexpr size_t tstepA = 2 * hstepA, tstepB = 2 * hstepB;
    const unsigned ldsw = (unsigned)wid * 1024u;
    const int aoff = lds_byte(wr * 64 + fr, fq * 8), boff = lds_byte(wc * 32 + fr, fq * 8);
#define PG8_SA(b, h) (((b) * 2 + (h)) * HTB)
#define PG8_SB(b, h) ((4 + (b) * 2 + (h)) * HTB)
#define PG8_STAGE(bufoff, gbase, voff) do { _Pragma("unroll") for (int _i = 0; _i < 2; ++_i) \
        __builtin_amdgcn_global_load_lds((const unsigned*)((const char*)(gbase) + (voff)[_i]), (LAS unsigned*)(lds + (bufoff) + ldsw + _i * 8192), 16, 0, 0); } while (0)
#define PG8_LDA(dst, b, h) do { _Pragma("unroll") for (int m = 0; m < 4; ++m) _Pragma("unroll") for (int k = 0; k < 2; ++k) dst[m][k] = *(const LAS bf16x8*)(lds + PG8_SA(b, h) + aoff + m * 2048 + k * 1024); } while (0)
#define PG8_LDB(dst, b, h) do { _Pragma("unroll") for (int n = 0; n < 2; ++n) _Pragma("unroll") for (int k = 0; k < 2; ++k) dst[n][k] = *(const LAS bf16x8*)(lds + PG8_SB(b, h) + boff + n * 2048 + k * 1024); } while (0)
#define PG8_MMA(ai, bj, At, Bt) do { __builtin_amdgcn_s_setprio(1); _Pragma("unroll") for (int m = 0; m < 4; ++m) _Pragma("unroll") for (int n = 0; n < 2; ++n) _Pragma("unroll") for (int k = 0; k < 2; ++k) \
        acc[ai][bj][m][n] = __builtin_amdgcn_mfma_f32_16x16x32_bf16(Bt[n][k], At[m][k], acc[ai][bj][m][n], 0, 0, 0); __builtin_amdgcn_s_setprio(0); } while (0)
#define PG8_WAIT_V(n) asm volatile("s_waitcnt vmcnt(" #n ")" ::: "memory")
#define PG8_WAIT_L(n) asm volatile("s_waitcnt lgkmcnt(" #n ")" ::: "memory")
#define PG8_BAR __builtin_amdgcn_s_barrier()
#define PG8_SCHED __builtin_amdgcn_sched_barrier(0)
    Unit cur, nxt; int ui = 0;
    if (!S.next(0, cur)) return;
    f32x4 acc[2][2][4][2];
#pragma unroll
    for (int a = 0; a < 2; ++a)
#pragma unroll
        for (int b = 0; b < 2; ++b)
#pragma unroll
            for (int m = 0; m < 4; ++m)
#pragma unroll
                for (int n = 0; n < 2; ++n) acc[a][b][m][n] = (f32x4){0.f, 0.f, 0.f, 0.f};
    bf16x8 At[4][2], B0[2][2], B1[2][2];
    const char* cA = (const char*)g.A + (size_t)cur.pm * tstepA; const char* cB = (const char*)g.Bt + (size_t)cur.pn * tstepB;
    if constexpr (SP2) {
        PG8_STAGE(PG8_SB(0, 0), cB, voffB); PG8_STAGE(PG8_SB(0, 1), cB + hstepB, voffB); PG8_STAGE(PG8_SA(0, 0), cA, voffA); PG8_STAGE(PG8_SA(0, 1), cA + hstepA, voffA);
        if (wr == 1) PG8_BAR;
        PG8_WAIT_V(2); PG8_BAR;
        PG8_STAGE(PG8_SB(1, 0), cB + kstep, voffB); PG8_STAGE(PG8_SA(1, 0), cA + kstep, voffA); PG8_STAGE(PG8_SB(1, 1), cB + hstepB + kstep, voffB);
        PG8_WAIT_V(6); PG8_BAR;
    } else {
        PG8_STAGE(PG8_SB(0, 0), cB, voffB); PG8_STAGE(PG8_SA(0, 0), cA, voffA); PG8_STAGE(PG8_SB(0, 1), cB + hstepB, voffB); PG8_STAGE(PG8_SA(0, 1), cA + hstepA, voffA);
        if (wr == 1) PG8_BAR;
        PG8_WAIT_V(4); PG8_BAR;
        PG8_STAGE(PG8_SB(1, 0), cB + kstep, voffB); PG8_STAGE(PG8_SA(1, 0), cA + kstep, voffA); PG8_STAGE(PG8_SB(1, 1), cB + hstepB + kstep, voffB);
        PG8_WAIT_V(6); PG8_BAR;
    }
    for (;;) {
        const bool has_next = S.next(ui + 1, nxt);
        const char* nA = has_next ? (const char*)g.A + (size_t)nxt.pm * tstepA : cA; const char* nB = has_next ? (const char*)g.Bt + (size_t)nxt.pn * tstepB : cB;
        for (int t = 0; t < nt; t += 2) {
            const bool last = (t == nt - 2);
            const char* a1 = cA + (size_t)(t + 1) * kstep;
            const char* a2 = last ? nA : cA + (size_t)(t + 2) * kstep; const char* b2 = last ? nB : cB + (size_t)(t + 2) * kstep;
            const char* a3 = a2 + kstep; const char* b3 = b2 + kstep;
            if constexpr (SP2) {
            PG8_LDB(B0, 0, 0); PG8_LDB(B1, 0, 1); PG8_SCHED; PG8_LDA(At, 0, 0); PG8_STAGE(PG8_SA(1, 1), a1 + hstepA, voffA);
            PG8_WAIT_V(8); PG8_WAIT_L(0); PG8_BAR; PG8_MMA(0, 0, At, B0); PG8_MMA(0, 1, At, B1); PG8_BAR; PG8_SCHED;
            PG8_LDA(At, 0, 1); PG8_STAGE(PG8_SB(0, 0), b2, voffB); PG8_STAGE(PG8_SB(0, 1), b2 + hstepB, voffB); PG8_STAGE(PG8_SA(0, 0), a2, voffA);
            PG8_WAIT_V(8); PG8_WAIT_L(0); PG8_BAR; PG8_MMA(1, 0, At, B0); PG8_MMA(1, 1, At, B1); PG8_BAR; PG8_SCHED;
            PG8_LDB(B0, 1, 0); PG8_LDB(B1, 1, 1); PG8_SCHED; PG8_LDA(At, 1, 0); PG8_STAGE(PG8_SA(0, 1), a2 + hstepA, voffA);
            PG8_WAIT_V(8); PG8_WAIT_L(0); PG8_BAR; PG8_MMA(0, 0, At, B0); PG8_MMA(0, 1, At, B1); PG8_BAR; PG8_SCHED;
            PG8_LDA(At, 1, 1); PG8_STAGE(PG8_SB(1, 0), b3, voffB); PG8_STAGE(PG8_SB(1, 1), b3 + hstepB, voffB); PG8_STAGE(PG8_SA(1, 0), a3, voffA);
            PG8_WAIT_V(8); PG8_WAIT_L(0); PG8_BAR; PG8_MMA(1, 0, At, B0); PG8_MMA(1, 1, At, B1); PG8_BAR; PG8_SCHED;
            } else {
            PG8_LDB(B0, 0, 0); PG8_SCHED; PG8_LDA(At, 0, 0); PG8_STAGE(PG8_SA(1, 1), a1 + hstepA, voffA);
            PG8_WAIT_L(8); PG8_BAR; PG8_WAIT_L(0); PG8_MMA(0, 0, At, B0); PG8_BAR; PG8_SCHED;
            PG8_LDB(B1, 0, 1); PG8_STAGE(PG8_SB(0, 0), b2, voffB);
            PG8_BAR; PG8_WAIT_L(0); PG8_MMA(0, 1, At, B1); PG8_BAR;
            PG8_LDA(At, 0, 1); PG8_STAGE(PG8_SA(0, 0), a2, voffA);
            PG8_BAR; PG8_WAIT_L(0); PG8_MMA(1, 0, At, B0); PG8_BAR; PG8_SCHED;
            PG8_STAGE(PG8_SB(0, 1), b2 + hstepB, voffB);
            PG8_WAIT_V(6); PG8_BAR; PG8_MMA(1, 1, At, B1); PG8_BAR;
            PG8_LDB(B0, 1, 0); PG8_SCHED; PG8_LDA(At, 1, 0); PG8_STAGE(PG8_SA(0, 1), a2 + hstepA, voffA);
            PG8_WAIT_L(8); PG8_BAR; PG8_WAIT_L(0); PG8_MMA(0, 0, At, B0); PG8_BAR; PG8_SCHED;
            PG8_LDB(B1, 1, 1); PG8_STAGE(PG8_SB(1, 0), b3, voffB);
            PG8_BAR; PG8_WAIT_L(0); PG8_MMA(0, 1, At, B1); PG8_BAR;
            PG8_LDA(At, 1, 1); PG8_STAGE(PG8_SA(1, 0), a3, voffA);
            PG8_BAR; PG8_WAIT_L(0); PG8_MMA(1, 0, At, B0); PG8_BAR; PG8_SCHED;
            PG8_STAGE(PG8_SB(1, 1), b3 + hstepB, voffB);
            PG8_WAIT_V(6); PG8_BAR; PG8_MMA(1, 1, At, B1); PG8_BAR;
            }
        }
        if constexpr (ALIGN_EPI) { if (wr == 0) PG8_BAR; }
        E(acc, cur, wr, wc, fr, fq);
        if (!has_next) break;
#pragma unroll
        for (int a = 0; a < 2; ++a)
#pragma unroll
            for (int b = 0; b < 2; ++b)
#pragma unroll
                for (int m = 0; m < 4; ++m)
#pragma unroll
                    for (int n = 0; n < 2; ++n) { typedef double f64x2_ __attribute__((ext_vector_type(2))); double d0_, d1_;
                        asm volatile("v_mov_b64 %0, 0" : "=v"(d0_)); asm volatile("v_mov_b64 %0, 0" : "=v"(d1_)); acc[a][b][m][n] = __builtin_bit_cast(f32x4, (f64x2_){d0_, d1_}); }
        cur = nxt; cA = nA; cB = nB; ++ui;
        if constexpr (ALIGN_EPI) { if (wr == 1) PG8_BAR; }
    }
    PG8_WAIT_V(0);
    if constexpr (!ALIGN_EPI) { if (wr == 0) PG8_BAR; }
    PG8_BAR;
#undef PG8_SA
#undef PG8_SB
#undef PG8_STAGE
#undef PG8_LDA
#undef PG8_LDB
#undef PG8_MMA
#undef PG8_WAIT_V
#undef PG8_WAIT_L
#undef PG8_BAR
#undef PG8_SCHED
}

template <int LDA, int LDB, int K>
__device__ __forceinline__ void skinny_rows(const bf16_t* A, const bf16_t* Bt, bf16_t* O, int ldc, int nu_mul, int nu_plain, int act, int plain_brow0, int plain_ocol0, int row_base,
                                            int wave, int lane, int bid, int G) {
    const int fr = lane & 15, fq = lane >> 4;
    const bf16_t* ap = A + (size_t)(row_base + 16 * wave + fr) * LDA + 8 * fq;
    for (int c = bid; c < nu_mul + nu_plain; c += G) {
        const bool mul = c < nu_mul;
        const int cc = mul ? c : c - nu_mul;
        const int brow = mul ? (((16 * cc) >> 7) << 8) + ((16 * cc) & 127) : plain_brow0 + 16 * cc;
        const int ocol = mul ? 16 * cc : plain_ocol0 + 16 * cc;
        const bf16_t* bp0 = Bt + (size_t)(brow + fr) * LDB + 8 * fq;
        const bf16_t* bp1 = bp0 + (size_t)128 * LDB;
        f32x4 acc0 = (f32x4){0.f, 0.f, 0.f, 0.f}, acc1 = (f32x4){0.f, 0.f, 0.f, 0.f};
        if (mul) {
            bf16x8 av[4], b0[4], b1[4], an[4], b0n[4], b1n[4];
#pragma unroll
            for (int i = 0; i < 4; ++i) { av[i] = *(const bf16x8*)(ap + 32 * i); b0[i] = *(const bf16x8*)(bp0 + 32 * i); b1[i] = *(const bf16x8*)(bp1 + 32 * i); }
            for (int k0 = 0; k0 < K; k0 += 128) {
                const int kn = (k0 + 128 < K) ? k0 + 128 : k0;
#pragma unroll
                for (int i = 0; i < 4; ++i) { an[i] = *(const bf16x8*)(ap + kn + 32 * i); b0n[i] = *(const bf16x8*)(bp0 + kn + 32 * i); b1n[i] = *(const bf16x8*)(bp1 + kn + 32 * i); }
#pragma unroll
                for (int i = 0; i < 4; ++i) { acc0 = __builtin_amdgcn_mfma_f32_16x16x32_bf16(b0[i], av[i], acc0, 0, 0, 0); acc1 = __builtin_amdgcn_mfma_f32_16x16x32_bf16(b1[i], av[i], acc1, 0, 0, 0); }
#pragma unroll
                for (int i = 0; i < 4; ++i) { av[i] = an[i]; b0[i] = b0n[i]; b1[i] = b1n[i]; }
            }
        } else {
            bf16x8 av[8], b0[8], an[8], b0n[8];
#pragma unroll
            for (int i = 0; i < 8; ++i) { av[i] = *(const bf16x8*)(ap + 32 * i); b0[i] = *(const bf16x8*)(bp0 + 32 * i); }
            for (int k0 = 0; k0 < K; k0 += 256) {
                const int kn = (k0 + 256 < K) ? k0 + 256 : k0;
#pragma unroll
                for (int i = 0; i < 8; ++i) { an[i] = *(const bf16x8*)(ap + kn + 32 * i); b0n[i] = *(const bf16x8*)(bp0 + kn + 32 * i); }
#pragma unroll
                for (int i = 0; i < 8; ++i) acc0 = __builtin_amdgcn_mfma_f32_16x16x32_bf16(b0[i], av[i], acc0, 0, 0, 0);
#pragma unroll
                for (int i = 0; i < 8; ++i) { av[i] = an[i]; b0[i] = b0n[i]; }
            }
        }
        float v[4];
#pragma unroll
        for (int e = 0; e < 4; ++e) { const float x = acc0[e], y = acc1[e]; v[e] = !mul ? x : (act == 0 ? x * y : (act == 1 ? x * fsig(x) * y : x * fsig(y))); }
        u32x2 w; w.x = cvt_pk_bf16(v[0], v[1]); w.y = cvt_pk_bf16(v[2], v[3]);
        *(u32x2*)(O + (size_t)(row_base + 16 * wave + fr) * ldc + ocol + 4 * fq) = w;
    }
}

template <int NT, int LDA, int LDB, int KS>
__device__ __forceinline__ void skinny_kslice(const bf16_t* ap, const bf16_t* bp, f32x4 (&acc)[4][4], const int xsrc) {
    constexpr int NG = KS / 64;
    bf16x8 a0[4][2], b0[NT][2], a1[4][2], b1[NT][2];
#define SK_LOAD(g_, av_, bv_) do { const int ko_ = 64 * (g_); \
        _Pragma("unroll") for (int rb = 0; rb < 4; ++rb) _Pragma("unroll") for (int ks = 0; ks < 2; ++ks) av_[rb][ks] = *(const bf16x8*)(ap + (size_t)rb * 16 * LDA + ko_ + 32 * ks); \
        _Pragma("unroll") for (int t = 0; t < NT; ++t) _Pragma("unroll") for (int ks = 0; ks < 2; ++ks) bv_[t][ks] = *(const bf16x8*)(bp + (size_t)(NT == 4 ? (t >> 1) * 128 + (t & 1) * 16 : t * 16) * LDB + ko_ + 32 * ks); } while (0)
#define SK_MMA(av_, bv_) do { _Pragma("unroll") for (int rb = 0; rb < 4; ++rb) _Pragma("unroll") for (int t = 0; t < NT; ++t) _Pragma("unroll") for (int ks = 0; ks < 2; ++ks) \
        acc[rb][t] = __builtin_amdgcn_mfma_f32_16x16x32_bf16(bv_[t][ks], av_[rb][ks], acc[rb][t], 0, 0, 0); } while (0)
#define SK_XP1(v_) do { u32x4 t_ = __builtin_bit_cast(u32x4, v_); t_ = lane_xpose(t_, xsrc); v_ = __builtin_bit_cast(bf16x8, t_); } while (0)
#define SK_XP(av_, bv_) do { _Pragma("unroll") for (int rb = 0; rb < 4; ++rb) _Pragma("unroll") for (int ks = 0; ks < 2; ++ks) SK_XP1(av_[rb][ks]); \
        _Pragma("unroll") for (int t = 0; t < NT; ++t) _Pragma("unroll") for (int ks = 0; ks < 2; ++ks) SK_XP1(bv_[t][ks]); } while (0)
    SK_LOAD(0, a0, b0);
    for (int g = 0; g < NG; g += 2) {
        const int g1 = (g + 1 < NG) ? g + 1 : g, g2 = (g + 2 < NG) ? g + 2 : g;
        SK_LOAD(g1, a1, b1); __builtin_amdgcn_sched_barrier(0);
        SK_XP(a0, b0); SK_MMA(a0, b0); __builtin_amdgcn_sched_barrier(0);
        SK_LOAD(g2, a0, b0); __builtin_amdgcn_sched_barrier(0);
        if (g + 1 < NG) { SK_XP(a1, b1); SK_MMA(a1, b1); }
        __builtin_amdgcn_sched_barrier(0);
    }
#undef SK_LOAD
#undef SK_MMA
#undef SK_XP
#undef SK_XP1
}
template <int LDA, int LDB, int K>
__device__ __forceinline__ void skinny2(const bf16_t* A, const bf16_t* Bt, bf16_t* O, int ldc, int ng_mul, int ng_plain, int act, int plain_brow0, int plain_ocol0, int row_base,
                                        LAS unsigned char* lds, int wave, int lane, int bid, int G) {
    constexpr int KS = K / 8;
    const int fr = lane & 15, fq = lane >> 4;
    LAS f32x4* red = (LAS f32x4*)lds;
    for (int c = bid; c < 2 * (ng_mul + ng_plain); c += G) {
        const int half = c & 1, cg = c >> 1; const bool mul = cg < ng_mul; const int oc0 = 32 * (mul ? cg : cg - ng_mul);
        const int brow = mul ? ((oc0 >> 7) << 8) + (oc0 & 127) : plain_brow0 + oc0;
        const int ocol = mul ? oc0 : plain_ocol0 + oc0;
        const int frl = 4 * fq + (fr >> 2), fql = fr & 3;
        const int xsrc = 4 * ((fr >> 2) * 16 + (fr & 3) * 4 + fq);
        const bf16_t* ap = A + (size_t)(row_base + 64 * half + frl) * LDA + wave * KS + 8 * fql;
        const bf16_t* bp = Bt + (size_t)(brow + frl) * LDB + wave * KS + 8 * fql;
        f32x4 acc[4][4];
#pragma unroll
        for (int rb = 0; rb < 4; ++rb)
#pragma unroll
            for (int t = 0; t < 4; ++t) acc[rb][t] = (f32x4){0.f, 0.f, 0.f, 0.f};
        if (mul) skinny_kslice<4, LDA, LDB, KS>(ap, bp, acc, xsrc); else skinny_kslice<2, LDA, LDB, KS>(ap, bp, acc, xsrc);
#pragma unroll
        for (int rb = 0; rb < 4; ++rb)
#pragma unroll
            for (int t = 0; t < 4; ++t) red[((wave * 4 + rb) * 4 + t) * 64 + lane] = acc[rb][t];
        asm volatile("s_waitcnt lgkmcnt(0)" ::: "memory"); __builtin_amdgcn_s_barrier(); asm volatile("" ::: "memory");
        const int rrb = wave & 3, j = wave >> 2;
        f32x4 va = (f32x4){0.f, 0.f, 0.f, 0.f}, vb = (f32x4){0.f, 0.f, 0.f, 0.f};
#pragma unroll
        for (int w2 = 0; w2 < 8; ++w2) { va += red[((w2 * 4 + rrb) * 4 + j) * 64 + lane]; vb += red[((w2 * 4 + rrb) * 4 + 2 + j) * 64 + lane]; }
        float v[4];
#pragma unroll
        for (int e = 0; e < 4; ++e) { const float x = va[e], y = vb[e]; v[e] = !mul ? x : (act == 0 ? x * y : (act == 1 ? x * fsig(x) * y : x * fsig(y))); }
        u32x2 w; w.x = cvt_pk_bf16(v[0], v[1]); w.y = cvt_pk_bf16(v[2], v[3]);
        *(u32x2*)(O + (size_t)(row_base + 64 * half + 16 * rrb + fr) * ldc + ocol + 16 * j + 4 * fq) = w;
        asm volatile("s_waitcnt lgkmcnt(0)" ::: "memory"); __builtin_amdgcn_s_barrier(); asm volatile("" ::: "memory");
    }
}
}

#ifndef PG8_SP2
#define PG8_SP2 true
#endif
#ifndef PG8_ALIGN
#define PG8_ALIGN true
#endif

constexpr int D = 2048, DFF = 5632, NBATCH = 8, SEQ = 4096, DSEQ = 16, DEPTH = 4;
constexpr int MP = NBATCH * SEQ;
constexpr int MS = NBATCH * DSEQ;
constexpr int MR = MP + MS;
constexpr int MPAD = 33024;
constexpr int AH = 4, ADK = 256, ADV = 512, AIN = 6152, AINP = 6144;
constexpr int S5G = 128, S5P = 16, S5N = 64, S5L = 32, S5K = 640;
constexpr float EPS = 1e-6f;

constexpr size_t O_Y = 0;
constexpr size_t O_PC = (size_t)MR * D;
constexpr size_t SZ_C = (size_t)2 * 8 * 4 * 256 * 512, SZ_N = 2 * 8 * 4 * 256, SZ_M = 2 * 8 * 4, SZ_CONV = 8 * 2 * 2048, SZ_S5 = 8 * 128 * 64;
constexpr size_t O_PN = O_PC + SZ_C, O_PM = O_PN + SZ_N, O_PCONV = O_PM + SZ_M, O_PRE = O_PCONV + SZ_CONV, O_PIM = O_PRE + SZ_S5;
constexpr size_t O_SC = O_PIM + SZ_S5, O_SN = O_SC + SZ_C, O_SM = O_SN + SZ_N, O_SCONV = O_SM + SZ_M, O_SRE = O_SCONV + SZ_CONV, O_SIM = O_SRE + SZ_S5;
constexpr size_t OUT_TOTAL = O_SIM + SZ_S5;

constexpr size_t MiB = 1u << 20;
constexpr size_t WS_CTL = 0, CTL_ZERO_BYTES = 1 * MiB;
constexpr size_t WS_MOD = 1 * MiB;
constexpr size_t WS_GT = 4 * MiB;
constexpr size_t WS_DEN = 6 * MiB;
constexpr size_t WS_MT = 7 * MiB;
constexpr size_t WS_HS = 8 * MiB;
constexpr size_t WS_KD = 9 * MiB;
constexpr size_t WS_PW = 13 * MiB;
constexpr size_t WS_COEF = 16 * MiB;
constexpr size_t WS_PWT = 17 * MiB;
constexpr size_t WS_WA_IN = 20 * MiB, WS_WA_OUT = 68 * MiB, WS_WB_IN = 84 * MiB, WS_WB_OUT = 108 * MiB, WS_WC_OUT = 116 * MiB, WS_WGU = 132 * MiB, WS_WDN = 308 * MiB;
constexpr size_t WS_S5T = 396 * MiB;
constexpr size_t WS_S5W = 476 * MiB;
constexpr size_t WS_H = 508 * MiB;
constexpr size_t WS_Z = 668 * MiB;
constexpr size_t WS_OUTB = 1055 * MiB;
constexpr size_t WS_XB = 1184 * MiB;
constexpr size_t WS_YB = WS_H;
constexpr size_t WS_YB2 = WS_Z + 128 * MiB;
constexpr size_t WS_END = 1313 * MiB;

constexpr int LDS_BYTES = 147456;
constexpr int SCR_OFF = 0;
constexpr int LCTL_OFF = LDS_BYTES - 256;

#define LDS_WAIT() asm volatile("s_waitcnt lgkmcnt(0)" ::: "memory")
#define LBAR() do { asm volatile("s_waitcnt lgkmcnt(0)" ::: "memory"); __builtin_amdgcn_s_barrier(); asm volatile("" ::: "memory"); } while (0)

#define XB_TMO      128
#define XB_XCNT(j)  (256  + 64 * (j))
#define XB_XSUB(j)  (1280 + 64 * (j))
#define XB_XGEN(j)  (2304 + 64 * (j))
#define XB_TOP      3328
#define XB_TOPGEN   3392
#define XCD_BAR_WORDS 3456
#define XB_SPIN_CAP (1u << 22)

__device__ __forceinline__ unsigned xb_ld(unsigned* p)              { return __hip_atomic_load(p, __ATOMIC_RELAXED, __HIP_MEMORY_SCOPE_AGENT); }
__device__ __forceinline__ unsigned xb_add(unsigned* p, unsigned v) { return __hip_atomic_fetch_add(p, v, __ATOMIC_RELAXED, __HIP_MEMORY_SCOPE_AGENT); }
__device__ __forceinline__ unsigned xb_xcc_id() { return (unsigned)__builtin_amdgcn_s_getreg((3 << 11) | 20) & 0xFu; }
#define XB_SPIN(cond, bar) do { unsigned _sp = 0; while (cond) { __builtin_amdgcn_s_sleep(1); \
    if ((++_sp & 255u) == 0u) { if (xb_ld(&(bar)[XB_TMO])) break; if (_sp > XB_SPIN_CAP) { atomicAdd(&(bar)[XB_TMO], 1u); break; } } } } while (0)

struct XcdBarrier { unsigned* bar; unsigned x; volatile LAS unsigned* st; };

__device__ __forceinline__ XcdBarrier xcd_barrier_post(unsigned* bar, volatile LAS unsigned* st) {
    XcdBarrier b; b.bar = bar; b.x = xb_xcc_id(); b.st = st;
    if (threadIdx.x == 0) (void)xb_add(&bar[XB_XCNT(b.x)], 1u);
    return b;
}
__device__ __forceinline__ void xcd_barrier_complete(unsigned* bar, unsigned x, unsigned& nloc, unsigned& nx) {
    const unsigned G = gridDim.x * gridDim.y * gridDim.z;
    unsigned sum, cnt, mine, sp = 0u;
    for (;;) {
        sum = 0u; cnt = 0u; mine = 0u;
#pragma unroll
        for (unsigned j = 0; j < 16; ++j) { const unsigned c = xb_ld(&bar[XB_XCNT(j)]); sum += c; cnt += (c > 0u) ? 1u : 0u; mine = (j == x) ? c : mine; }
        if (sum == G) break;
        __builtin_amdgcn_s_sleep(1);
        if ((++sp & 255u) == 0u) { if (xb_ld(&bar[XB_TMO])) break; if (sp > XB_SPIN_CAP) { atomicAdd(&bar[XB_TMO], 1u); break; } }
    }
    nloc = mine > 0u ? mine : 1u; nx = cnt > 0u ? cnt : 1u;
}
__device__ __forceinline__ void xcd_barrier(const XcdBarrier& b) {
    asm volatile("s_waitcnt vmcnt(0)" ::: "memory");
    __syncthreads();
    if (threadIdx.x == 0) {
        unsigned* bar = b.bar;
        __builtin_amdgcn_s_waitcnt(0);
        unsigned nloc = b.st[0], nx = b.st[1];
        if (nloc == 0u) { xcd_barrier_complete(bar, b.x, nloc, nx); b.st[0] = nloc; b.st[1] = nx; }
        const unsigned old = xb_add(&bar[XB_XSUB(b.x)], 1u);
        const unsigned gen = old / nloc;
        if (old + 1u == (gen + 1u) * nloc) {
            __builtin_amdgcn_fence(__ATOMIC_RELEASE, "agent");
            asm volatile("s_waitcnt vmcnt(0)" ::: "memory");
            const unsigned og = xb_add(&bar[XB_TOP], 1u);
            const unsigned tg = og / nx;
            if (og + 1u == (tg + 1u) * nx) xb_add(&bar[XB_TOPGEN], 1u);
            else XB_SPIN(xb_ld(&bar[XB_TOPGEN]) == tg, bar);
            __builtin_amdgcn_fence(__ATOMIC_ACQUIRE, "agent");
            xb_add(&bar[XB_XGEN(b.x)], 1u);
            asm volatile("s_waitcnt vmcnt(0)" ::: "memory");
        } else {
            XB_SPIN(xb_ld(&bar[XB_XGEN(b.x)]) == gen, bar);
            __builtin_amdgcn_fence(__ATOMIC_ACQUIRE, "agent");
            asm volatile("s_waitcnt vmcnt(0)" ::: "memory");
        }
    }
    __syncthreads();
}

struct Args { const void* in[32]; float* out; unsigned char* ws; int ph_lo, ph_hi, li, pad; };


__device__ __forceinline__ float wave_sum(float v) {
#pragma unroll
    for (int o = 1; o < 64; o <<= 1) v += __shfl_xor(v, o);
    return v;
}
__device__ __forceinline__ float bf2f(unsigned short b) { return __uint_as_float((unsigned)b << 16); }
__device__ __forceinline__ float bflo(unsigned w) { return __uint_as_float(w << 16); }
__device__ __forceinline__ float bfhi(unsigned w) { return __uint_as_float(w & 0xffff0000u); }
__device__ __forceinline__ unsigned pk2(float lo, float hi) { return pg8::cvt_pk_bf16(lo, hi); }
__device__ __forceinline__ float fsig(float x) { return __builtin_amdgcn_rcpf(1.0f + __builtin_amdgcn_exp2f(-1.44269504f * x)); }

__device__ __forceinline__ void tr_item(const float* W, int ldw, int k0, int n0, bf16_t* WT, int Kd, int drow0, float scale, LAS float* scr, int lane) {
    float wv[32];
#pragma unroll
    for (int i = 0; i < 32; ++i) wv[i] = W[(size_t)(k0 + 2 * i + (lane >> 5)) * ldw + n0 + (lane & 31)];
#pragma unroll
    for (int i = 0; i < 32; ++i) scr[(2 * i + (lane >> 5)) * 33 + (lane & 31)] = wv[i] * scale;
    LDS_WAIT(); asm volatile("" ::: "memory");
    const int c = lane & 7;
#pragma unroll
    for (int j = 0; j < 4; ++j) { const int n = (lane >> 3) + 8 * j; const LAS float* s = scr + (8 * c) * 33 + n;
        u32x4 o; o.x = pk2(s[0 * 33], s[1 * 33]); o.y = pk2(s[2 * 33], s[3 * 33]); o.z = pk2(s[4 * 33], s[5 * 33]); o.w = pk2(s[6 * 33], s[7 * 33]);
        *(u32x4*)(WT + (size_t)(drow0 + n) * Kd + k0 + 8 * c) = o; }
    LDS_WAIT(); asm volatile("" ::: "memory");
}
__device__ __forceinline__ int map_pair(int c, int second) { return ((c >> 7) << 8) + (second ? 128 : 0) + (c & 127); }

__device__ __forceinline__ void p0_weights(const Args& a, LAS unsigned char* lds, int wave, int lane, int G, int bid) {
    LAS float* scr = (LAS float*)(lds + SCR_OFF + wave * 8448);
    const int nslot = bid < 64 ? 3 : 2, slot0 = bid < 64 ? 3 * bid : 192 + 2 * (bid - 64), NSLOT = (G > 64 ? 192 + 2 * (G - 64) : 3 * G) * 8;
    const float* wA_in = (const float*)a.in[13]; const float* wA_out = (const float*)a.in[16]; const float* wB_in = (const float*)a.in[17]; const float* wB_out = (const float*)a.in[19];
    const float* wC_out = (const float*)a.in[28]; const float* wg = (const float*)a.in[29]; const float* wu = (const float*)a.in[30]; const float* wd = (const float*)a.in[31];
    bf16_t* WA_IN = (bf16_t*)(a.ws + WS_WA_IN); bf16_t* WA_OUT = (bf16_t*)(a.ws + WS_WA_OUT); bf16_t* WB_IN = (bf16_t*)(a.ws + WS_WB_IN); bf16_t* WB_OUT = (bf16_t*)(a.ws + WS_WB_OUT);
    bf16_t* WC_OUT = (bf16_t*)(a.ws + WS_WC_OUT); bf16_t* WGU = (bf16_t*)(a.ws + WS_WGU); bf16_t* WDN = (bf16_t*)(a.ws + WS_WDN);
    constexpr int I_AIN = 32 * 192, I_AOUT = 32 * 64, I_BIN = 32 * 192, I_BOUT = 32 * 64, I_COUT = 32 * 128, I_G = 32 * 176, I_DN = 88 * 64;
    constexpr int NITEMS = 2 * I_AIN + 2 * I_AOUT + I_BIN + I_BOUT + I_COUT + 4 * I_G + 4 * I_G + 4 * I_DN;
    for (int sl = 0; sl < nslot; ++sl)
    for (int it = (slot0 + sl) * 8 + wave; it < NITEMS; it += NSLOT) {
        int r = it;
        if (r < 2 * I_AIN) { const int j = r / I_AIN; r -= j * I_AIN; const int kb = r / 192, nb = r % 192; const int n0 = nb * 32;
            tr_item(wA_in + (size_t)j * D * AIN, AIN, kb * 64, n0, WA_IN + (size_t)j * AINP * D, D, n0, n0 < 1024 ? 0.0625f : 1.0f, scr, lane); continue; }
        r -= 2 * I_AIN;
        if (r < 2 * I_AOUT) { const int j = r / I_AOUT; r -= j * I_AOUT; const int kb = r / 64, nb = r % 64;
            tr_item(wA_out + (size_t)j * D * D, D, kb * 64, nb * 32, WA_OUT + (size_t)j * D * D, D, nb * 32, 1.0f, scr, lane); continue; }
        r -= 2 * I_AOUT;
        if (r < I_BIN) { const int kb = r / 192, nb = r % 192; const int n0 = nb * 32;
            const int drow = n0 < 2048 ? 4096 + n0 : (n0 < 4096 ? map_pair(n0 - 2048, 0) : map_pair(n0 - 4096, 1));
            tr_item(wB_in, 6144, kb * 64, n0, WB_IN, D, drow, 1.0f, scr, lane); continue; }
        r -= I_BIN;
        if (r < I_BOUT) { const int kb = r / 64, nb = r % 64; tr_item(wB_out, D, kb * 64, nb * 32, WB_OUT, D, nb * 32, 1.0f, scr, lane); continue; }
        r -= I_BOUT;
        if (r < I_COUT) { const int kb = r / 128, nb = r % 128; const int n0 = nb * 32;
            const int drow = n0 < 2048 ? map_pair(n0, 0) : map_pair(n0 - 2048, 1);
            tr_item(wC_out, 4096, kb * 64, n0, WC_OUT, D, drow, 1.0f, scr, lane); continue; }
        r -= I_COUT;
        if (r < 4 * I_G) { const int i = r / I_G; r -= i * I_G; const int kb = r / 176, nb = r % 176;
            tr_item(wg + (size_t)i * D * DFF, DFF, kb * 64, nb * 32, WGU + (size_t)i * 2 * DFF * D, D, map_pair(nb * 32, 0), 1.0f, scr, lane); continue; }
        r -= 4 * I_G;
        if (r < 4 * I_G) { const int i = r / I_G; r -= i * I_G; const int kb = r / 176, nb = r % 176;
            tr_item(wu + (size_t)i * D * DFF, DFF, kb * 64, nb * 32, WGU + (size_t)i * 2 * DFF * D, D, map_pair(nb * 32, 1), 1.0f, scr, lane); continue; }
        r -= 4 * I_G;
        { const int i = r / I_DN; r -= i * I_DN; const int kb = r / 64, nb = r % 64;
            tr_item(wd + (size_t)i * DFF * D, D, kb * 64, nb * 32, WDN + (size_t)i * D * DFF, DFF, nb * 32, 1.0f, scr, lane); }
    }
}

__device__ __forceinline__ void p0_mod_task(const Args& a, LAS unsigned char* lds, int task, int tid, int wave, int lane) {
    const float* cP = (const float*)a.in[8]; const float* cS = (const float*)a.in[9]; const float* w_mod = (const float*)a.in[10]; const float* b_mod = (const float*)a.in[11];
    float* MOD = (float*)(a.ws + WS_MOD);
    const int i = task / 48, cb = task % 48;
    LAS float* s = (LAS float*)(lds + SCR_OFF);
    for (int e = tid; e < 2048 * 16; e += 512) { const int k = e >> 4, r = e & 15; const float c = r < 8 ? cP[r * D + k] : cS[(r - 8) * D + k]; s[e] = c * fsig(c); }
    LBAR();
    f32x4 acc[16];
#pragma unroll
    for (int r = 0; r < 16; ++r) acc[r] = (f32x4){0.f, 0.f, 0.f, 0.f};
    const int n = cb * 256 + 4 * lane;
    const float* wp = w_mod + ((size_t)i * D + wave * 256) * (6 * D) + n;
#pragma unroll 4
    for (int kk = 0; kk < 256; ++kk) {
        const f32x4 w = *(const f32x4*)(wp + (size_t)kk * (6 * D));
        const LAS f32x4* sp = (const LAS f32x4*)(s + (wave * 256 + kk) * 16);
        const f32x4 s0 = sp[0], s1 = sp[1], s2 = sp[2], s3 = sp[3];
        acc[0] += s0[0] * w; acc[1] += s0[1] * w; acc[2] += s0[2] * w; acc[3] += s0[3] * w;
        acc[4] += s1[0] * w; acc[5] += s1[1] * w; acc[6] += s1[2] * w; acc[7] += s1[3] * w;
        acc[8] += s2[0] * w; acc[9] += s2[1] * w; acc[10] += s2[2] * w; acc[11] += s2[3] * w;
        acc[12] += s3[0] * w; acc[13] += s3[1] * w; acc[14] += s3[2] * w; acc[15] += s3[3] * w;
    }
    LBAR();
    LAS float* red = (LAS float*)(lds + SCR_OFF);
#pragma unroll
    for (int r = 0; r < 16; ++r) *(LAS f32x4*)(red + (wave * 16 + r) * 256 + 4 * lane) = acc[r];
    LBAR();
    for (int e = tid; e < 16 * 256; e += 512) { const int r = e >> 8, c = e & 255; float v = b_mod[i * 6 * D + cb * 256 + c];
#pragma unroll
        for (int w = 0; w < 8; ++w) v += red[(w * 16 + r) * 256 + c];
        MOD[((size_t)i * 16 + r) * (6 * D) + cb * 256 + c] = v; }
    LBAR();
}


__device__ __forceinline__ void dsincos(double x, double& sn, double& cs) {
    const double kq = rint(x * 0.63661977236758134308);
    const double r = (x - kq * 1.57079632673412561417e+00) - kq * 6.07710050650619224932e-11;
    const int q = (int)((long long)kq & 3);
    const double r2 = r * r;
    const double ps = r + r * r2 * (-1.66666666666666324348e-01 + r2 * (8.33333333332248946124e-03 + r2 * (-1.98412698298579493134e-04 + r2 * (2.75573137070700676789e-06 + r2 * (-2.50507602534068634195e-08 + r2 * 1.58969099521155010221e-10)))));
    const double pc = 1.0 - 0.5 * r2 + r2 * r2 * (4.16666666666666019037e-02 + r2 * (-1.38888888888741095749e-03 + r2 * (2.48015872894767294178e-05 + r2 * (-2.75573143513906633035e-07 + r2 * (2.08757232129817482790e-09 + r2 * -1.13596475577881948265e-11)))));
    sn = (q == 0) ? ps : (q == 1) ? pc : (q == 2) ? -ps : -pc;
    cs = (q == 0) ? pc : (q == 1) ? -ps : (q == 2) ? -pc : ps;
}
__device__ __forceinline__ void p0_s5_group(const Args& a, LAS unsigned char* lds, int g, int tid) {
    const float* A_re = (const float*)a.in[20]; const float* A_im = (const float*)a.in[21]; const float* B_re = (const float*)a.in[22]; const float* B_im = (const float*)a.in[23];
    const float* C_re = (const float*)a.in[24]; const float* C_im = (const float*)a.in[25]; const float* Dsk = (const float*)a.in[26]; const float* log_dt = (const float*)a.in[27];
    f32x2* PW = (f32x2*)(a.ws + WS_PW); f32x2* COEF = (f32x2*)(a.ws + WS_COEF); float* KD = (float*)(a.ws + WS_KD);
    LAS f32x2* pw = (LAS f32x2*)(lds + SCR_OFF);
    LAS f32x2* cf = (LAS f32x2*)(lds + SCR_OFF + 64 * 33 * 8);
    LAS f32x2* bb = (LAS f32x2*)(lds + SCR_OFF + 64 * 33 * 8 + 512);
    const double dt = exp((double)log_dt[g]);
    for (int e = tid; e < 64 * 33; e += 512) {
        const int n = e / 33, d = e % 33;
        const double lr = (double)A_re[g * 64 + n], li = (double)A_im[g * 64 + n];
        const double mag = exp(lr * dt * (double)d), ang = li * dt * (double)d;
        double sn, cs; dsincos(ang, sn, cs);
        const f32x2 v = {(float)(mag * cs), (float)(mag * sn)};
        pw[n * 33 + d] = v; PW[((size_t)g * 64 + n) * 33 + d] = v; ((f32x2*)(a.ws + WS_PWT))[((size_t)g * 33 + d) * 64 + n] = v;
        if (d == 1) { const double ar = mag * cs, ai = mag * sn, nr = ar - 1.0, den = lr * lr + li * li;
            const f32x2 c = {(float)((nr * lr + ai * li) / den), (float)((ai * lr - nr * li) / den)}; cf[n] = c; COEF[g * 64 + n] = c; }
    }
    LBAR();
    for (int e = tid; e < 64 * 16; e += 512) { const int n = e >> 4; const float br = B_re[(size_t)g * 1024 + e], bi = B_im[(size_t)g * 1024 + e]; const f32x2 c = cf[n];
        bb[e] = (f32x2){c.x * br - c.y * bi, c.x * bi + c.y * br}; }
    LBAR();
    for (int e = tid; e < 32 * 256; e += 512) {
        const int d = e >> 8, p = (e >> 4) & 15, pp = e & 15;
        float acc = 0.f;
        for (int n = 0; n < 64; ++n) {
            const float cr = C_re[((size_t)g * 16 + p) * 64 + n], ci = C_im[((size_t)g * 16 + p) * 64 + n];
            const f32x2 P = pw[n * 33 + d], B = bb[n * 16 + pp];
            const float er = cr * P.x - ci * P.y, ei = cr * P.y + ci * P.x;
            acc += er * B.x - ei * B.y;
        }
        if (d == 0 && p == pp) acc += Dsk[g * 16 + p];
        KD[(size_t)g * 8192 + e] = acc;
    }
    LBAR();
}

__device__ __forceinline__ void p1_s5_tables(const Args& a, int gtid, int gthreads) {
    const float* B_re = (const float*)a.in[22]; const float* B_im = (const float*)a.in[23]; const float* C_re = (const float*)a.in[24]; const float* C_im = (const float*)a.in[25];
    const f32x2* PW = (const f32x2*)(a.ws + WS_PW); const f32x2* COEF = (const f32x2*)(a.ws + WS_COEF); const float* KD = (const float*)(a.ws + WS_KD);
    bf16_t* T = (bf16_t*)(a.ws + WS_S5T); bf16_t* W = (bf16_t*)(a.ws + WS_S5W);
    for (int q = gtid; q < 128 * 512 * 80; q += gthreads) {
        const int g = q / 40960, rem = q % 40960, row = rem / 80, ch = rem % 80, t = row >> 4, p = row & 15, col0 = ch * 8;
        float v[8];
        if (col0 < 512) { const int s = col0 >> 4, p0 = col0 & 15;
            if (s <= t) { const float* src = KD + (((size_t)g * 32 + (t - s)) * 16 + p) * 16 + p0; const f32x4 x = *(const f32x4*)src, y = *(const f32x4*)(src + 4);
                v[0] = x[0]; v[1] = x[1]; v[2] = x[2]; v[3] = x[3]; v[4] = y[0]; v[5] = y[1]; v[6] = y[2]; v[7] = y[3]; }
            else {
#pragma unroll
                for (int e = 0; e < 8; ++e) v[e] = 0.f; }
        } else { const int nn0 = col0 - 512, n0 = nn0 & 63, im = nn0 >> 6;
#pragma unroll
            for (int e = 0; e < 8; ++e) { const int n = n0 + e; const f32x2 P = ((const f32x2*)(a.ws + WS_PWT))[((size_t)g * 33 + t + 1) * 64 + n];
                const float cr = C_re[((size_t)g * 16 + p) * 64 + n], ci = C_im[((size_t)g * 16 + p) * 64 + n];
                v[e] = im ? -(cr * P.y + ci * P.x) : (cr * P.x - ci * P.y); }
        }
        u32x4 o; o.x = pk2(v[0], v[1]); o.y = pk2(v[2], v[3]); o.z = pk2(v[4], v[5]); o.w = pk2(v[6], v[7]);
        *(u32x4*)(T + ((size_t)g * 512 + row) * S5K + col0) = o;
    }
    for (int q = gtid; q < 128 * 256 * 64; q += gthreads) {
        const int g = q >> 14, rem = q & 16383, nn = rem >> 6, ch = rem & 63, col0 = ch * 8, s = col0 >> 4, p0 = col0 & 15;
        float v[8];
        if (nn >= 128) {
#pragma unroll
            for (int e = 0; e < 8; ++e) v[e] = 0.f;
        } else { const int n = nn & 63, im = nn >> 6; const f32x2 P = PW[((size_t)g * 64 + n) * 33 + 31 - s], c = COEF[g * 64 + n];
#pragma unroll
            for (int e = 0; e < 8; ++e) { const float br = B_re[((size_t)g * 64 + n) * 16 + p0 + e], bi = B_im[((size_t)g * 64 + n) * 16 + p0 + e];
                const float bbr = c.x * br - c.y * bi, bbi = c.x * bi + c.y * br;
                v[e] = im ? (P.x * bbi + P.y * bbr) : (P.x * bbr - P.y * bbi); }
        }
        u32x4 o; o.x = pk2(v[0], v[1]); o.y = pk2(v[2], v[3]); o.z = pk2(v[4], v[5]); o.w = pk2(v[6], v[7]);
        *(u32x4*)(W + ((size_t)g * 256 + nn) * 512 + col0) = o;
    }
}

struct RowPass {
    const float* xP; const float* xS;
    const bf16_t* outb;
    const float* gnA; const float* gate;
    const float* gnB; const float* sh; const float* sc;
    int hmode;
    const float* wgate; const float* bgate;
};
template <bool FIRST>
__device__ __forceinline__ void row_pass(const Args& a, const RowPass& R, LAS unsigned char* lds, int tid, int wave, int lane, int G, int bid) {
    float* Y = a.out; bf16_t* XB = (bf16_t*)(a.ws + WS_XB); bf16_t* H = (bf16_t*)(a.ws + WS_H); float* GT = (float*)(a.ws + WS_GT); float* HS = (float*)(a.ws + WS_HS);
    LAS float* vec = (LAS float*)(lds + SCR_OFF);
    LAS float* wgl = vec + 5 * 2048;
    const bool has_out = R.outb != nullptr, has_h = R.gnB != nullptr;
    if (R.hmode == 1) {
#pragma unroll 4
        for (int q = 0; q < 32; ++q) { const int e = tid + 512 * q; const int k = e >> 3, jj = e & 7; wgl[jj * 2048 + k] = R.wgate[(size_t)k * AIN + jj]; } }
    for (int blk = bid; blk < 256 + 16; blk += G) {
        const bool smp = blk >= 256; const int b16 = smp ? 8 + ((blk - 256) >> 1) : (blk >> 5);
        const int nrows = smp ? 1 : 16, m0 = smp ? MP + (blk - 256) * 8 + wave : blk * 128 + wave;
        struct Raw { u32x4 x[FIRST ? 8 : 4]; u32x4 o[4]; };
#define RP_LOAD(m_, rw) do { const int mm_ = (m_); \
            if constexpr (FIRST) { const float* xs_ = (mm_ < MP ? R.xP + (size_t)mm_ * D : R.xS + (size_t)(mm_ - MP) * D); \
                _Pragma("unroll") for (int j = 0; j < 4; ++j) { rw.x[2 * j] = *(const u32x4*)(xs_ + 8 * lane + 512 * j); rw.x[2 * j + 1] = *(const u32x4*)(xs_ + 8 * lane + 512 * j + 4); } } \
            else { const bf16_t* xr_ = XB + (size_t)mm_ * D; _Pragma("unroll") for (int j = 0; j < 4; ++j) rw.x[j] = __builtin_nontemporal_load((const u32x4*)(xr_ + 8 * lane + 512 * j)); } \
            if (has_out) { const bf16_t* or_ = R.outb + (size_t)mm_ * D; _Pragma("unroll") for (int j = 0; j < 4; ++j) rw.o[j] = *(const u32x4*)(or_ + 8 * lane + 512 * j); } \
            else { _Pragma("unroll") for (int j = 0; j < 4; ++j) rw.o[j] = (u32x4){0u, 0u, 0u, 0u}; } } while (0)
#define RP_PK4(j_) ((u32x4){pk2(v[4 * (j_)].x, v[4 * (j_)].y), pk2(v[4 * (j_) + 1].x, v[4 * (j_) + 1].y), pk2(v[4 * (j_) + 2].x, v[4 * (j_) + 2].y), pk2(v[4 * (j_) + 3].x, v[4 * (j_) + 3].y)})
        Raw ra, rb;
        RP_LOAD(m0, ra);
        LBAR();
        { const float* gp = has_out ? R.gate + (size_t)b16 * (6 * D) : nullptr; const float* scp = has_h ? R.sc + (size_t)b16 * (6 * D) : nullptr; const float* shp = has_h ? R.sh + (size_t)b16 * (6 * D) : nullptr;
        int tl_ = tid; asm volatile("" : "+v"(tl_));
#pragma unroll
        for (int q = 0; q < 4; ++q) { const unsigned e = (unsigned)tl_ + 512u * q;
            vec[0 * 2048 + e] = has_out ? gp[e] * R.gnA[e] : 0.f;
            vec[1 * 2048 + e] = has_h ? R.gnB[e] * (1.0f + scp[e]) : 0.f;
            vec[2 * 2048 + e] = has_h ? shp[e] : 0.f; } }
        LBAR();
        for (int i = 0; i < nrows; ++i) {
            const int m = m0 + 8 * i;
            asm volatile("" ::: "memory");
            if (i + 1 < nrows) RP_LOAD(m + 8, rb); else rb = ra;
            f32x2 v[16];
#pragma unroll
            for (int j = 0; j < 4; ++j) {
                if constexpr (FIRST) {
                    v[4 * j]     = (f32x2){__uint_as_float(ra.x[2 * j][0]), __uint_as_float(ra.x[2 * j][1])};     v[4 * j + 1] = (f32x2){__uint_as_float(ra.x[2 * j][2]), __uint_as_float(ra.x[2 * j][3])};
                    v[4 * j + 2] = (f32x2){__uint_as_float(ra.x[2 * j + 1][0]), __uint_as_float(ra.x[2 * j + 1][1])}; v[4 * j + 3] = (f32x2){__uint_as_float(ra.x[2 * j + 1][2]), __uint_as_float(ra.x[2 * j + 1][3])};
                } else {
#pragma unroll
                    for (int e = 0; e < 4; ++e) v[4 * j + e] = (f32x2){bflo(ra.x[j][e]), bfhi(ra.x[j][e])};
                }
            }
            if (has_out) {
                f32x2 o[16]; f32x2 s2 = (f32x2){0.f, 0.f};
#pragma unroll
                for (int j = 0; j < 4; ++j)
#pragma unroll
                    for (int e = 0; e < 4; ++e) o[4 * j + e] = (f32x2){bflo(ra.o[j][e]), bfhi(ra.o[j][e])};
#pragma unroll
                for (int k = 0; k < 16; ++k) s2 += o[k] * o[k];
                const float r1 = rsqrtf(wave_sum(s2.x + s2.y) * (1.0f / D) + EPS);
                const f32x2 r1v = (f32x2){r1, r1};
#pragma unroll
                for (int j = 0; j < 4; ++j)
#pragma unroll
                    for (int q = 0; q < 2; ++q) { const f32x4 g = *(const LAS f32x4*)(vec + 8 * lane + 512 * j + 4 * q);
                        v[4 * j + 2 * q]     += (o[4 * j + 2 * q] * r1v) * (f32x2){g[0], g[1]};
                        v[4 * j + 2 * q + 1] += (o[4 * j + 2 * q + 1] * r1v) * (f32x2){g[2], g[3]}; }
            }
            if (has_h) { bf16_t* xw_ = XB + (size_t)m * D;
#pragma unroll
                for (int j = 0; j < 4; ++j) __builtin_nontemporal_store(RP_PK4(j), (u32x4*)(xw_ + 8 * lane + 512 * j));
            } else {
#pragma unroll
                for (int j = 0; j < 4; ++j) { *(f32x4*)(Y + (size_t)m * D + 8 * lane + 512 * j) = (f32x4){v[4 * j].x, v[4 * j].y, v[4 * j + 1].x, v[4 * j + 1].y};
                    *(f32x4*)(Y + (size_t)m * D + 8 * lane + 512 * j + 4) = (f32x4){v[4 * j + 2].x, v[4 * j + 2].y, v[4 * j + 3].x, v[4 * j + 3].y}; }
            }
            if (has_h) {
                f32x2 s2 = (f32x2){0.f, 0.f};
#pragma unroll
                for (int k = 0; k < 16; ++k) s2 += v[k] * v[k];
                const float r2 = rsqrtf(wave_sum(s2.x + s2.y) * (1.0f / D) + EPS);
                const f32x2 r2v = (f32x2){r2, r2};
#pragma unroll
                for (int j = 0; j < 4; ++j)
#pragma unroll
                    for (int q = 0; q < 2; ++q) { const int cb = 8 * lane + 512 * j + 4 * q;
                        const f32x4 c1 = *(const LAS f32x4*)(vec + 1 * 2048 + cb), s0 = *(const LAS f32x4*)(vec + 2 * 2048 + cb);
                        v[4 * j + 2 * q]     = (v[4 * j + 2 * q] * r2v) * (f32x2){c1[0], c1[1]} + (f32x2){s0[0], s0[1]};
                        v[4 * j + 2 * q + 1] = (v[4 * j + 2 * q + 1] * r2v) * (f32x2){c1[2], c1[3]} + (f32x2){s0[2], s0[3]}; }
                if (R.hmode == 2 && smp) {
#pragma unroll
                    for (int j = 0; j < 4; ++j) { *(f32x4*)(HS + (size_t)(m - MP) * D + 8 * lane + 512 * j) = (f32x4){v[4 * j].x, v[4 * j].y, v[4 * j + 1].x, v[4 * j + 1].y};
                        *(f32x4*)(HS + (size_t)(m - MP) * D + 8 * lane + 512 * j + 4) = (f32x4){v[4 * j + 2].x, v[4 * j + 2].y, v[4 * j + 3].x, v[4 * j + 3].y}; }
                } else {
                    const int b = m >> 12, tp = m & 4095, c = tp >> 5, sq = tp & 31, inst = b * 128 + c;
                    bf16_t* hb = R.hmode == 2 ? H + (size_t)inst * S5K + sq * 16 : H + (size_t)m * D;
                    const unsigned loff = R.hmode == 2 ? (unsigned)(lane >> 1) * (unsigned)(1024 * S5K) + 8u * (unsigned)(lane & 1) : 8u * (unsigned)lane;
                    const size_t jstr = R.hmode == 2 ? (size_t)32 * 1024 * S5K : (size_t)512;
#pragma unroll
                    for (int j = 0; j < 4; ++j) *(u32x4*)(hb + j * jstr + loff) = RP_PK4(j);
                    if (R.hmode == 1) {
                        float ga[8];
#pragma unroll
                        for (int jj = 0; jj < 8; ++jj) { f32x2 sa = (f32x2){0.f, 0.f};
#pragma unroll
                            for (int j = 0; j < 4; ++j)
#pragma unroll
                                for (int q = 0; q < 2; ++q) { const f32x4 w = *(const LAS f32x4*)(wgl + jj * 2048 + 8 * lane + 512 * j + 4 * q);
                                    sa += v[4 * j + 2 * q] * (f32x2){w[0], w[1]}; sa += v[4 * j + 2 * q + 1] * (f32x2){w[2], w[3]}; }
                            ga[jj] = wave_sum(sa.x + sa.y); }
                        if (lane < 8) { float gsel = ga[0];
#pragma unroll
                            for (int jj = 1; jj < 8; ++jj) gsel = (lane == jj) ? ga[jj] : gsel;
                            gsel += R.bgate[lane];
                            if (lane >= 4) gsel = fminf(gsel, 0.f) - log1pf(__expf(-fabsf(gsel)));
                            GT[(size_t)m * 8 + lane] = gsel; }
                    }
                }
            }
            ra = rb;
        }
#undef RP_LOAD
#undef RP_PK4
    }
    LBAR();
}

__device__ __forceinline__ bf16x8 tr_read2(unsigned addr0, unsigned addr1) {
    bf16x4 lo, hi;
    asm volatile("ds_read_b64_tr_b16 %0, %2\n\tds_read_b64_tr_b16 %1, %3\n\ts_waitcnt lgkmcnt(0)" : "=&v"(lo), "=&v"(hi) : "v"(addr0), "v"(addr1) : "memory");
    return (bf16x8){lo[0], lo[1], lo[2], lo[3], hi[0], hi[1], hi[2], hi[3]};
}
__device__ __forceinline__ void tr_read4(unsigned a0, unsigned a1, unsigned a2, unsigned a3, bf16x8& x, bf16x8& y) {
    bf16x4 r0, r1, r2, r3;
    asm volatile("ds_read_b64_tr_b16 %0, %4\n\tds_read_b64_tr_b16 %1, %5\n\tds_read_b64_tr_b16 %2, %6\n\tds_read_b64_tr_b16 %3, %7\n\ts_waitcnt lgkmcnt(0)"
                 : "=&v"(r0), "=&v"(r1), "=&v"(r2), "=&v"(r3) : "v"(a0), "v"(a1), "v"(a2), "v"(a3) : "memory");
    x = (bf16x8){r0[0], r0[1], r0[2], r0[3], r1[0], r1[1], r1[2], r1[3]}; y = (bf16x8){r2[0], r2[1], r2[2], r2[3], r3[0], r3[1], r3[2], r3[3]};
}
template <int O0, int O1, int O2, int O3>
__device__ __forceinline__ void tr_read4o(unsigned base, bf16x8& x, bf16x8& y) {
    bf16x4 r0, r1, r2, r3;
    asm volatile("ds_read_b64_tr_b16 %0, %4 offset:%5\n\tds_read_b64_tr_b16 %1, %4 offset:%6\n\tds_read_b64_tr_b16 %2, %4 offset:%7\n\tds_read_b64_tr_b16 %3, %4 offset:%8\n\ts_waitcnt lgkmcnt(0)"
                 : "=&v"(r0), "=&v"(r1), "=&v"(r2), "=&v"(r3) : "v"(base), "i"(O0), "i"(O1), "i"(O2), "i"(O3) : "memory");
    x = (bf16x8){r0[0], r0[1], r0[2], r0[3], r1[0], r1[1], r1[2], r1[3]}; y = (bf16x8){r2[0], r2[1], r2[2], r2[3], r3[0], r3[1], r3[2], r3[3]};
}
struct GateVec { float bcs, av, Mv; float Mlast, mnew, mprev; };
template <int CTRL, int ROWMASK> __device__ __forceinline__ float dpp_take(float ident, float v) {
    return __builtin_bit_cast(float, __builtin_amdgcn_update_dpp(__builtin_bit_cast(int, ident), __builtin_bit_cast(int, v), CTRL, ROWMASK, 0xF, false));
}
__device__ __forceinline__ float scan_add64(float v) {
    v += dpp_take<0x111, 0xF>(0.f, v); v += dpp_take<0x112, 0xF>(0.f, v); v += dpp_take<0x114, 0xF>(0.f, v); v += dpp_take<0x118, 0xF>(0.f, v);
    v += dpp_take<0x142, 0xA>(0.f, v); v += dpp_take<0x143, 0xC>(0.f, v);
    return v;
}
__device__ __forceinline__ float scan_max64(float v) {
    const float ninf = -INFINITY;
    v = fmaxf(v, dpp_take<0x111, 0xF>(ninf, v)); v = fmaxf(v, dpp_take<0x112, 0xF>(ninf, v)); v = fmaxf(v, dpp_take<0x114, 0xF>(ninf, v)); v = fmaxf(v, dpp_take<0x118, 0xF>(ninf, v));
    v = fmaxf(v, dpp_take<0x142, 0xA>(ninf, v)); v = fmaxf(v, dpp_take<0x143, 0xC>(ninf, v));
    return v;
}
__device__ __forceinline__ GateVec gate_vectors(float li_v, float lf_v, float mprev, int TV, int lane) {
    GateVec g;
    const float bcs = scan_add64(lf_v);
    const float av = (lane < TV) ? li_v - bcs : -INFINITY;
    const float pm = scan_max64(av);
    const float Mv = fmaxf(mprev, pm);
    const float Mlast = __builtin_bit_cast(float, __builtin_amdgcn_readlane(__builtin_bit_cast(int, Mv), TV - 1));
    const float blast = __builtin_bit_cast(float, __builtin_amdgcn_readlane(__builtin_bit_cast(int, bcs), TV - 1));
    g.bcs = bcs; g.av = av; g.Mv = Mv; g.Mlast = Mlast; g.mnew = blast + Mlast; g.mprev = mprev;
    return g;
}
__device__ __forceinline__ void mlstm_scan(const Args& a, LAS unsigned char* lds, int j, int tid, int w, int lane, int G, int bid) {
    constexpr int QS = 0, KS = 33792, CTO = 67584, VS = 109824, VW = 121088, SP = 132352;
    constexpr int QSTR = 528, VSTR = 176, SSTR = 144;
    LAS unsigned char* L = lds + SCR_OFF;
    const unsigned Lb = (unsigned)(size_t)L;
    const bf16_t* Z = (const bf16_t*)(a.ws + WS_Z); const float* GT = (const float*)(a.ws + WS_GT);
    bf16_t* NUM = (bf16_t*)(a.ws + WS_OUTB); float* DEN = (float*)(a.ws + WS_DEN); float* MTb = (float*)(a.ws + WS_MT);
    const float* stC = (const float*)a.in[2]; const float* stN = (const float*)a.in[3]; const float* stM = (const float*)a.in[4];
    const int fr = lane & 15, fq = lane >> 4, qq = (lane & 15) >> 2, pp = lane & 3;
    const int tb = w >> 1, half = w & 1;
    for (int unit = bid; unit < 512; unit += G) {
        const bool smp = unit >= 256; const int uu = unit & 255, b = uu >> 5, h = (uu >> 3) & 3, dvs = uu & 7;
        const int row0 = smp ? MP + b * 16 : b * 4096, nch = smp ? 1 : 64, TV = smp ? 16 : 64;
        const int NT = dvs == 0 ? 5 : 4;
        const size_t sidx = (size_t)((j * 8 + b) * 4 + h);
        f32x4 cacc[5][2];
        float mprev = 0.f;
#pragma unroll
        for (int i = 0; i < 5; ++i)
#pragma unroll
            for (int jj = 0; jj < 2; ++jj) cacc[i][jj] = (f32x4){0.f, 0.f, 0.f, 0.f};
        if (smp) {
            const float* C0 = stC + sidx * 256 * 512;
#pragma unroll
            for (int i = 0; i < 4; ++i)
#pragma unroll
                for (int jj = 0; jj < 2; ++jj)
#pragma unroll
                    for (int r = 0; r < 4; ++r) cacc[i][jj][r] = C0[(size_t)(32 * w + 16 * jj + 4 * fq + r) * 512 + dvs * 64 + 16 * i + fr];
            if (NT == 5 && fr == 0) {
#pragma unroll
                for (int jj = 0; jj < 2; ++jj) cacc[4][jj] = *(const f32x4*)(stN + sidx * 256 + 32 * w + 16 * jj + 4 * fq);
            }
            mprev = stM[sidx];
        }
        u32x4 qreg[4], kreg[4], vreg; float li_v = 0.f, lf_v = 0.f, li_n = 0.f, lf_n = 0.f;
        const int srow = tid >> 3, sch = tid & 7;
#define ISSUE_LOADS(ch_) do { \
            const size_t grow_ = (size_t)(row0 + (ch_) * 64 + srow); \
            if (srow < TV) { \
                const bf16_t* zr = Z + grow_ * AINP; \
                _Pragma("unroll") for (int i = 0; i < 4; ++i) { qreg[i] = *(const u32x4*)(zr + h * 256 + (sch + 8 * i) * 8); kreg[i] = *(const u32x4*)(zr + 1024 + h * 256 + (sch + 8 * i) * 8); } \
                vreg = *(const u32x4*)(zr + 2048 + h * 512 + dvs * 64 + sch * 8); \
            } else { \
                _Pragma("unroll") for (int i = 0; i < 4; ++i) { qreg[i] = (u32x4){0u, 0u, 0u, 0u}; kreg[i] = (u32x4){0u, 0u, 0u, 0u}; } \
                vreg = (u32x4){0u, 0u, 0u, 0u}; \
            } \
        } while (0)
#define ISSUE_GATES(ch_, li_, lf_) do { if (lane < TV && (ch_) < nch) { const size_t gr_ = (size_t)(row0 + (ch_) * 64 + lane); li_ = GT[gr_ * 8 + h]; lf_ = GT[gr_ * 8 + 4 + h]; } else { li_ = 0.f; lf_ = 0.f; } } while (0)
        ISSUE_LOADS(0);
        ISSUE_GATES(0, li_v, lf_v); ISSUE_GATES(1, li_n, lf_n);
        GateVec gv = gate_vectors(li_v, lf_v, mprev, TV, lane);
#pragma unroll
        for (int i = 0; i < 5; ++i)
#pragma unroll
            for (int jj = 0; jj < 2; ++jj) { u32x2 wv; wv.x = pk2(cacc[i][jj][0], cacc[i][jj][1]); wv.y = pk2(cacc[i][jj][2], cacc[i][jj][3]);
                *(LAS u32x2*)(L + CTO + (16 * i + fr) * QSTR + (32 * w + 16 * jj + 4 * fq) * 2) = wv; }
        for (int ch = 0; ch < nch; ++ch) {
            LBAR();
            const float bcs = gv.bcs, av = gv.av, Mv = gv.Mv, wl = __expf(gv.av - gv.Mlast), decay = __expf(gv.mprev - gv.Mlast);
            if (dvs == 0 && w == 0 && lane < TV) MTb[(size_t)(row0 + ch * 64 + lane) * 4 + h] = bcs + Mv;
#pragma unroll
            for (int i = 0; i < 4; ++i) { *(LAS u32x4*)(L + QS + srow * QSTR + (sch + 8 * i) * 16) = qreg[i]; *(LAS u32x4*)(L + KS + srow * QSTR + (sch + 8 * i) * 16) = kreg[i]; }
            {
                const float wls = __shfl(wl, srow);
                *(LAS u32x4*)(L + VS + srow * VSTR + sch * 16) = vreg;
                u32x4 vw;
                vw.x = pk2(bflo(vreg.x) * wls, bfhi(vreg.x) * wls); vw.y = pk2(bflo(vreg.y) * wls, bfhi(vreg.y) * wls);
                vw.z = pk2(bflo(vreg.z) * wls, bfhi(vreg.z) * wls); vw.w = pk2(bflo(vreg.w) * wls, bfhi(vreg.w) * wls);
                *(LAS u32x4*)(L + VW + srow * VSTR + sch * 16) = vw;
                if (sch < 2) {
                    u32x4 one = (u32x4){0u, 0u, 0u, 0u}, wo = (u32x4){0u, 0u, 0u, 0u};
                    if (sch == 0 && srow < TV) { one.x = 0x3F80u; wo.x = pk2(wls, 0.f); }
                    *(LAS u32x4*)(L + VS + srow * VSTR + 128 + sch * 16) = one;
                    *(LAS u32x4*)(L + VW + srow * VSTR + 128 + sch * 16) = wo;
                }
            }
            if (ch + 1 < nch) ISSUE_LOADS(ch + 1);
            LBAR();
            const GateVec gn = gate_vectors(li_n, lf_n, gv.mnew, TV, lane);
            ISSUE_GATES(ch + 2, li_n, lf_n);
            bf16x8 qf[8];
#pragma unroll
            for (int kk = 0; kk < 8; ++kk) qf[kk] = *(const LAS bf16x8*)(L + QS + (16 * tb + fr) * QSTR + (32 * kk + 8 * fq) * 2);
            const int trow = 16 * tb + fr;
            const float Mt = __shfl(Mv, trow);
#pragma unroll
            for (int e = 0; e < 2; ++e) {
                const int sb = 2 * half + e;
                u32x2 wv = (u32x2){0u, 0u};
                if (sb <= tb) {
                    f32x4 s = (f32x4){0.f, 0.f, 0.f, 0.f};
#pragma unroll
                    for (int kk = 0; kk < 8; ++kk) { const bf16x8 kf = *(const LAS bf16x8*)(L + KS + (16 * sb + fr) * QSTR + (32 * kk + 8 * fq) * 2);
                        s = __builtin_amdgcn_mfma_f32_16x16x32_bf16(kf, qf[kk], s, 0, 0, 0); }
                    float pv[4];
#pragma unroll
                    for (int r = 0; r < 4; ++r) { const int sc = 16 * sb + 4 * fq + r; const float as = __shfl(av, sc); pv[r] = (sc <= trow) ? s[r] * __expf(as - Mt) : 0.f; }
                    wv.x = pk2(pv[0], pv[1]); wv.y = pk2(pv[2], pv[3]);
                }
                *(LAS u32x2*)(L + SP + trow * SSTR + (16 * sb + 4 * fq) * 2) = wv;
            }
            f32x4 nacc[3];
            const float iwt = __expf(gv.mprev - Mt);
#pragma unroll
            for (int q = 0; q < 3; ++q) {
                nacc[q] = (f32x4){0.f, 0.f, 0.f, 0.f};
                const int i = q < 2 ? 2 * half + q : 4;
                if (q < 2 || (half == 0 && NT == 5)) {
#pragma unroll
                    for (int kk = 0; kk < 8; ++kk) { const bf16x8 cfr = *(const LAS bf16x8*)(L + CTO + (16 * i + fr) * QSTR + (32 * kk + 8 * fq) * 2);
                        nacc[q] = __builtin_amdgcn_mfma_f32_16x16x32_bf16(cfr, qf[kk], nacc[q], 0, 0, 0); }
                    nacc[q] = nacc[q] * iwt;
                }
            }
            LBAR();
            const unsigned bvs = Lb + VS + (8 * fq + qq) * VSTR + (4 * pp) * 2;
            const unsigned bks = Lb + KS + (8 * fq + qq) * QSTR + (32 * w + 4 * pp) * 2;
            {
                const bf16x8 sf0 = *(const LAS bf16x8*)(L + SP + trow * SSTR + (8 * fq) * 2), sf1 = *(const LAS bf16x8*)(L + SP + trow * SSTR + (32 + 8 * fq) * 2);
                const unsigned bvh = bvs + 64 * half;
                const bool aug = (half == 0 && NT == 5);
                bf16x8 va0, va1, vb0, vb1, vc0, vc1;
#define V_READ(base_, off_, x_, y_) tr_read4o<(off_), (off_) + 4 * VSTR, (off_) + 32 * VSTR, (off_) + 36 * VSTR>(base_, x_, y_)
                V_READ(bvh, 0, va0, va1);
                nacc[0] = __builtin_amdgcn_mfma_f32_16x16x32_bf16(va0, sf0, nacc[0], 0, 0, 0); nacc[0] = __builtin_amdgcn_mfma_f32_16x16x32_bf16(va1, sf1, nacc[0], 0, 0, 0);
                V_READ(bvh, 32, vb0, vb1);
                nacc[1] = __builtin_amdgcn_mfma_f32_16x16x32_bf16(vb0, sf0, nacc[1], 0, 0, 0); nacc[1] = __builtin_amdgcn_mfma_f32_16x16x32_bf16(vb1, sf1, nacc[1], 0, 0, 0);
                if (aug) { V_READ(bvs, 128, vc0, vc1);
                    nacc[2] = __builtin_amdgcn_mfma_f32_16x16x32_bf16(vc0, sf0, nacc[2], 0, 0, 0); nacc[2] = __builtin_amdgcn_mfma_f32_16x16x32_bf16(vc1, sf1, nacc[2], 0, 0, 0); }
#undef V_READ
                bf16x8 kt[2][2], vwf[2], vwn[2];
                tr_read4o<0, 4 * QSTR, 32 * QSTR, 36 * QSTR>(bks, kt[0][0], kt[0][1]);
                tr_read4o<32, 32 + 4 * QSTR, 32 + 32 * QSTR, 32 + 36 * QSTR>(bks, kt[1][0], kt[1][1]);
#define W_READ(i_, x_, y_) tr_read4o<(VW - VS) + 32 * (i_), (VW - VS) + 32 * (i_) + 4 * VSTR, (VW - VS) + 32 * (i_) + 32 * VSTR, (VW - VS) + 32 * (i_) + 36 * VSTR>(bvs, x_, y_)
                W_READ(0, vwf[0], vwf[1]);
                if (trow < TV) {
                    const size_t grow = (size_t)(row0 + ch * 64 + trow);
#pragma unroll
                    for (int q = 0; q < 2; ++q) { u32x2 wv; wv.x = pk2(nacc[q][0], nacc[q][1]); wv.y = pk2(nacc[q][2], nacc[q][3]);
                        *(u32x2*)(NUM + grow * D + h * 512 + dvs * 64 + 16 * (2 * half + q) + 4 * fq) = wv; }
                    if (aug && fq == 0) DEN[grow * 4 + h] = nacc[2][0];
                }
#define E4_MMA(i_) do { _Pragma("unroll") for (int jj = 0; jj < 2; ++jj) { cacc[i_][jj] = cacc[i_][jj] * decay; \
                        _Pragma("unroll") for (int kk = 0; kk < 2; ++kk) cacc[i_][jj] = __builtin_amdgcn_mfma_f32_16x16x32_bf16(kt[jj][kk], vwf[kk], cacc[i_][jj], 0, 0, 0); } } while (0)
#define E4_PUT(i_) do { _Pragma("unroll") for (int jj = 0; jj < 2; ++jj) { u32x2 wv; wv.x = pk2(cacc[i_][jj][0], cacc[i_][jj][1]); wv.y = pk2(cacc[i_][jj][2], cacc[i_][jj][3]); \
                        *(LAS u32x2*)(L + CTO + (16 * (i_) + fr) * QSTR + (32 * w + 16 * jj + 4 * fq) * 2) = wv; } } while (0)
                E4_MMA(0); W_READ(1, vwn[0], vwn[1]); E4_PUT(0); vwf[0] = vwn[0]; vwf[1] = vwn[1];
                E4_MMA(1); W_READ(2, vwn[0], vwn[1]); E4_PUT(1); vwf[0] = vwn[0]; vwf[1] = vwn[1];
                E4_MMA(2); W_READ(3, vwn[0], vwn[1]); E4_PUT(2); vwf[0] = vwn[0]; vwf[1] = vwn[1];
                if (NT == 5) { E4_MMA(3); W_READ(4, vwn[0], vwn[1]); E4_PUT(3); vwf[0] = vwn[0]; vwf[1] = vwn[1]; E4_MMA(4); E4_PUT(4); }
                else { E4_MMA(3); E4_PUT(3); }
#undef E4_MMA
#undef E4_PUT
#undef W_READ
            }
            mprev = gv.mnew; gv = gn;
        }
        {
            float* oC = a.out + (smp ? O_SC : O_PC) + sidx * 256 * 512;
#pragma unroll
            for (int i = 0; i < 4; ++i)
#pragma unroll
                for (int jj = 0; jj < 2; ++jj)
#pragma unroll
                    for (int r = 0; r < 4; ++r) oC[(size_t)(32 * w + 16 * jj + 4 * fq + r) * 512 + dvs * 64 + 16 * i + fr] = cacc[i][jj][r];
            if (NT == 5 && fr == 0) {
                float* oN = a.out + (smp ? O_SN : O_PN) + sidx * 256;
#pragma unroll
                for (int jj = 0; jj < 2; ++jj) *(f32x4*)(oN + 32 * w + 16 * jj + 4 * fq) = cacc[4][jj];
            }
            if (dvs == 0 && tid == 0) a.out[(smp ? O_SM : O_PM) + sidx] = mprev;
        }
        LBAR();
    }
}

__device__ __forceinline__ void mlstm_headnorm(const Args& a, int j, int wave, int lane, int G, int bid) {
    const bf16_t* NUM = (const bf16_t*)(a.ws + WS_OUTB); const float* DEN = (const float*)(a.ws + WS_DEN); const float* MTb = (const float*)(a.ws + WS_MT);
    const bf16_t* Z = (const bf16_t*)(a.ws + WS_Z); bf16_t* YB = (bf16_t*)(a.ws + WS_YB); const float* gh = (const float*)a.in[15] + (size_t)j * D;
    const int hh = lane >> 4, c0 = hh * 512 + (lane & 15) * 8;
    float g[32];
#pragma unroll
    for (int q = 0; q < 8; ++q) { const f32x4 t = *(const f32x4*)(gh + c0 + 128 * (q >> 1) + 4 * (q & 1)); g[4 * q] = t[0]; g[4 * q + 1] = t[1]; g[4 * q + 2] = t[2]; g[4 * q + 3] = t[3]; }
    for (int tk = bid; tk < 256 + G; tk += G) {
        const bool smp = tk >= 256;
        const int gwi = (tk - 256) * 8 + wave;
        if (smp && gwi >= MS) continue;
        const int m0 = smp ? MP + gwi : tk * 128 + wave, nrows = smp ? 1 : 16;
        struct Raw { u32x4 n[4], o[4]; float den, mt; };
#define HN_LOAD(m_, rw) do { const bf16_t* np_ = NUM + (size_t)(m_) * D + c0; const bf16_t* op_ = Z + (size_t)(m_) * AINP + 4096 + c0; \
            _Pragma("unroll") for (int q = 0; q < 4; ++q) { rw.n[q] = *(const u32x4*)(np_ + 128 * q); rw.o[q] = *(const u32x4*)(op_ + 128 * q); } \
            rw.den = DEN[(size_t)(m_) * 4 + hh]; rw.mt = MTb[(size_t)(m_) * 4 + hh]; } while (0)
        Raw ra, rb;
        HN_LOAD(m0, ra);
        for (int i = 0; i < nrows; ++i) {
            const int m = m0 + 8 * i;
            if (i + 1 < nrows) HN_LOAD(m + 8, rb); else rb = ra;
            const float inv = 1.0f / fmaxf(fabsf(ra.den), __expf(-ra.mt));
            float hv[32]; float ss = 0.f;
#pragma unroll
            for (int q = 0; q < 4; ++q)
#pragma unroll
                for (int e = 0; e < 4; ++e) { hv[8 * q + 2 * e] = bflo(ra.n[q][e]) * inv; hv[8 * q + 2 * e + 1] = bfhi(ra.n[q][e]) * inv; }
#pragma unroll
            for (int k = 0; k < 32; ++k) ss += hv[k] * hv[k];
            ss += __shfl_xor(ss, 1); ss += __shfl_xor(ss, 2); ss += __shfl_xor(ss, 4); ss += __shfl_xor(ss, 8);
            const float rs = rsqrtf(ss * (1.0f / 512.0f) + EPS);
#pragma unroll
            for (int q = 0; q < 4; ++q) {
                float r[8];
#pragma unroll
                for (int e = 0; e < 4; ++e) { r[2 * e] = hv[8 * q + 2 * e] * rs * g[8 * q + 2 * e] * fsig(bflo(ra.o[q][e])); r[2 * e + 1] = hv[8 * q + 2 * e + 1] * rs * g[8 * q + 2 * e + 1] * fsig(bfhi(ra.o[q][e])); }
                u32x4 o; o.x = pk2(r[0], r[1]); o.y = pk2(r[2], r[3]); o.z = pk2(r[4], r[5]); o.w = pk2(r[6], r[7]);
                *(u32x4*)(YB + (size_t)m * D + c0 + 128 * q) = o; }
            ra = rb;
        }
#undef HN_LOAD
    }
}

__device__ __forceinline__ void conv_pass(const Args& a, LAS unsigned char* lds, int tid, int wave, int lane, int G, int bid) {
    const bf16_t* Z = (const bf16_t*)(a.ws + WS_Z); bf16_t* YB = (bf16_t*)(a.ws + WS_YB); const float* wc = (const float*)a.in[18]; const float* stc = (const float*)a.in[5];
    LAS float* wl = (LAS float*)(lds + SCR_OFF);
    for (int e = tid; e < 3 * 2048; e += 512) { const int c = e / 3, k = e - 3 * c; wl[k * 2048 + c] = wc[e]; }
    LBAR();
    for (int tk = bid; tk < 256 + G; tk += G) {
        const bool smp = tk >= 256;
        const int gwi = (tk - 256) * 8 + wave;
        if (smp && gwi >= MS) continue;
        const int m0 = smp ? MP + gwi : tk * 128 + wave * 16, nrows = smp ? 1 : 16;
        const int bb = smp ? gwi >> 4 : m0 >> 12, t0 = smp ? gwi & 15 : m0 & 4095, Lq = smp ? 16 : 4096;
        u32x4 z1[4], z2[4];
#pragma unroll
        for (int j = 0; j < 4; ++j) {
            const float* p1 = stc + ((size_t)bb * 2 + 1) * D + 8 * lane + 512 * j; const float* p0 = stc + ((size_t)bb * 2 + 0) * D + 8 * lane + 512 * j;
            if (t0 >= 1) z1[j] = *(const u32x4*)(Z + (size_t)(m0 - 1) * 4096 + 8 * lane + 512 * j);
            else if (smp) z1[j] = (u32x4){pk2(p1[0], p1[1]), pk2(p1[2], p1[3]), pk2(p1[4], p1[5]), pk2(p1[6], p1[7])};
            else z1[j] = (u32x4){0u, 0u, 0u, 0u};
            if (t0 >= 2) z2[j] = *(const u32x4*)(Z + (size_t)(m0 - 2) * 4096 + 8 * lane + 512 * j);
            else if (smp && t0 == 1) z2[j] = (u32x4){pk2(p1[0], p1[1]), pk2(p1[2], p1[3]), pk2(p1[4], p1[5]), pk2(p1[6], p1[7])};
            else if (smp) z2[j] = (u32x4){pk2(p0[0], p0[1]), pk2(p0[2], p0[3]), pk2(p0[4], p0[5]), pk2(p0[6], p0[7])};
            else z2[j] = (u32x4){0u, 0u, 0u, 0u};
        }
        struct Raw { u32x4 z[4], g[4]; };
#define CV_LOAD(m_, rw) do { const bf16_t* zp_ = Z + (size_t)(m_) * 4096 + 8 * lane; _Pragma("unroll") for (int j = 0; j < 4; ++j) { rw.z[j] = *(const u32x4*)(zp_ + 512 * j); rw.g[j] = *(const u32x4*)(zp_ + 2048 + 512 * j); } } while (0)
        Raw ra, rb;
        CV_LOAD(m0, ra);
        for (int i = 0; i < nrows; ++i) {
            const int m = m0 + i, t = t0 + i;
            asm volatile("" ::: "memory");
            if (i + 1 < nrows) CV_LOAD(m + 1, rb); else rb = ra;
#pragma unroll
            for (int j = 0; j < 4; ++j) {
                float y[8];
#pragma unroll
                for (int q = 0; q < 2; ++q) {
                    const f32x4 k0 = *(const LAS f32x4*)(wl + 8 * lane + 512 * j + 4 * q), k1 = *(const LAS f32x4*)(wl + 2048 + 8 * lane + 512 * j + 4 * q), k2 = *(const LAS f32x4*)(wl + 4096 + 8 * lane + 512 * j + 4 * q);
#pragma unroll
                    for (int e = 0; e < 2; ++e) { const unsigned w0 = ra.z[j][2 * q + e], w1 = z1[j][2 * q + e], w2 = z2[j][2 * q + e], wg = ra.g[j][2 * q + e];
                        y[4 * q + 2 * e] = bflo(wg) * (bflo(w2) * k0[2 * e] + bflo(w1) * k1[2 * e] + bflo(w0) * k2[2 * e]);
                        y[4 * q + 2 * e + 1] = bfhi(wg) * (bfhi(w2) * k0[2 * e + 1] + bfhi(w1) * k1[2 * e + 1] + bfhi(w0) * k2[2 * e + 1]); }
                }
                u32x4 o; o.x = pk2(y[0], y[1]); o.y = pk2(y[2], y[3]); o.z = pk2(y[4], y[5]); o.w = pk2(y[6], y[7]);
                *(u32x4*)(YB + (size_t)m * D + 8 * lane + 512 * j) = o;
                if (t >= Lq - 2) { float* op = a.out + (smp ? O_SCONV : O_PCONV) + ((size_t)bb * 2 + (t - (Lq - 2))) * D + 8 * lane + 512 * j;
                    *(f32x4*)op = (f32x4){bflo(ra.z[j].x), bfhi(ra.z[j].x), bflo(ra.z[j].y), bfhi(ra.z[j].y)}; *(f32x4*)(op + 4) = (f32x4){bflo(ra.z[j].z), bfhi(ra.z[j].z), bflo(ra.z[j].w), bfhi(ra.z[j].w)}; }
                z2[j] = z1[j]; z1[j] = ra.z[j];
            }
            ra = rb;
        }
#undef CV_LOAD
    }
    LBAR();
}

__device__ __forceinline__ void s5_scan(const Args& a, int it, int tid) {
    const int gid = it * 512 + tid, n = gid & 63, g = (gid >> 6) & 127, b = gid >> 13;
    const f32x2* PW = (const f32x2*)(a.ws + WS_PW); const float* XL = (const float*)(a.ws + WS_Z); bf16_t* HG = (bf16_t*)(a.ws + WS_H);
    const f32x2 A32 = ((const f32x2*)(a.ws + WS_PWT))[((size_t)g * 33 + 32) * 64 + n];
    float xr = 0.f, xi = 0.f;
#pragma unroll 8
    for (int c = 0; c < 128; ++c) {
        const size_t inst = (size_t)g * 1024 + b * 128 + c;
        HG[inst * S5K + 512 + n] = (bf16_t)(pk2(xr, 0.f) & 0xffffu); HG[inst * S5K + 576 + n] = (bf16_t)(pk2(xi, 0.f) & 0xffffu);
        const float lr = XL[inst * 128 + n], li = XL[inst * 128 + 64 + n];
        const float nr = A32.x * xr - A32.y * xi + lr, ni = A32.x * xi + A32.y * xr + li;
        xr = nr; xi = ni;
    }
    a.out[O_PRE + ((size_t)b * 128 + g) * 64 + n] = xr; a.out[O_PIM + ((size_t)b * 128 + g) * 64 + n] = xi;
}
__device__ __forceinline__ void s5_sample(const Args& a, LAS unsigned char* lds, int it, int wave, int lane) {
    const int wv = it * 8 + wave, b = wv >> 7, g = wv & 127, n = lane;
    const f32x2* PW = (const f32x2*)(a.ws + WS_PW); const f32x2* COEF = (const f32x2*)(a.ws + WS_COEF); const float* HS = (const float*)(a.ws + WS_HS); bf16_t* YB = (bf16_t*)(a.ws + WS_YB2);
    const float* B_re = (const float*)a.in[22]; const float* B_im = (const float*)a.in[23]; const float* C_re = (const float*)a.in[24]; const float* C_im = (const float*)a.in[25]; const float* Dsk = (const float*)a.in[26];
    LAS float* U = (LAS float*)(lds + SCR_OFF + wave * 9216);
    LAS float* Xre = U + 256; LAS float* Xim = U + 256 + 1024;
    *(LAS f32x4*)(U + (lane >> 2) * 16 + (lane & 3) * 4) = *(const f32x4*)(HS + (size_t)(b * 16 + (lane >> 2)) * D + g * 16 + (lane & 3) * 4);
    const f32x2 Ab = ((const f32x2*)(a.ws + WS_PWT))[((size_t)g * 33 + 1) * 64 + n], cf = COEF[g * 64 + n];
    float bbr[16], bbi[16];
#pragma unroll
    for (int q = 0; q < 4; ++q) { const f32x4 br4 = *(const f32x4*)(B_re + ((size_t)g * 64 + n) * 16 + 4 * q), bi4 = *(const f32x4*)(B_im + ((size_t)g * 64 + n) * 16 + 4 * q);
#pragma unroll
        for (int e = 0; e < 4; ++e) { bbr[4 * q + e] = cf.x * br4[e] - cf.y * bi4[e]; bbi[4 * q + e] = cf.x * bi4[e] + cf.y * br4[e]; } }
    float xr = ((const float*)a.in[6])[((size_t)b * 128 + g) * 64 + n], xi = ((const float*)a.in[7])[((size_t)b * 128 + g) * 64 + n];
    LDS_WAIT(); asm volatile("" ::: "memory");
#pragma unroll 2
    for (int t = 0; t < 16; ++t) {
        float br = 0.f, bi = 0.f;
#pragma unroll
        for (int q = 0; q < 4; ++q) { const f32x4 u4 = *(const LAS f32x4*)(U + t * 16 + 4 * q);
#pragma unroll
            for (int e = 0; e < 4; ++e) { br += bbr[4 * q + e] * u4[e]; bi += bbi[4 * q + e] * u4[e]; } }
        const float nr = Ab.x * xr - Ab.y * xi + br, ni = Ab.x * xi + Ab.y * xr + bi; xr = nr; xi = ni;
        Xre[t * 64 + n] = xr; Xim[t * 64 + n] = xi;
    }
    a.out[O_SRE + ((size_t)b * 128 + g) * 64 + n] = xr; a.out[O_SIM + ((size_t)b * 128 + g) * 64 + n] = xi;
    LDS_WAIT(); asm volatile("" ::: "memory");
    const int p = lane & 15, tq = lane >> 4;
    float acc[4] = {0.f, 0.f, 0.f, 0.f};
#pragma unroll 2
    for (int q = 0; q < 16; ++q) {
        const f32x4 c4 = *(const f32x4*)(C_re + ((size_t)g * 16 + p) * 64 + 4 * q), d4 = *(const f32x4*)(C_im + ((size_t)g * 16 + p) * 64 + 4 * q);
#pragma unroll
        for (int tt = 0; tt < 4; ++tt) { const f32x4 xr4 = *(const LAS f32x4*)(Xre + (4 * tq + tt) * 64 + 4 * q), xi4 = *(const LAS f32x4*)(Xim + (4 * tq + tt) * 64 + 4 * q);
            acc[tt] += (c4[0] * xr4[0] - d4[0] * xi4[0]) + (c4[1] * xr4[1] - d4[1] * xi4[1]) + (c4[2] * xr4[2] - d4[2] * xi4[2]) + (c4[3] * xr4[3] - d4[3] * xi4[3]); }
    }
    const float dsk = Dsk[g * 16 + p];
#pragma unroll
    for (int tt = 0; tt < 4; ++tt) { const int t = 4 * tq + tt; const float y = acc[tt] + dsk * U[t * 16 + p];
        const float uu = 0.7978845608f * (y + 0.044715f * y * y * y); const float gl = y * fsig(2.0f * uu);
        YB[(size_t)(MP + b * 16 + t) * D + g * 16 + p] = (bf16_t)(pk2(gl, 0.f) & 0xffffu); }
    LDS_WAIT(); asm volatile("" ::: "memory");
}

#define PH_BEGIN if (ph >= lo && ph < hi) { Args args = args0; int tid = tid0, bid = bid0, G = G0; unsigned zlo_ = 0; asm volatile("" : "+v"(tid)); asm volatile("" : "+s"(zlo_)); asm volatile("" : "+s"(bid)); asm volatile("" : "+s"(G)); \
    bid = __builtin_amdgcn_readfirstlane(bid); G = __builtin_amdgcn_readfirstlane(G); const size_t zoff_ = (size_t)(unsigned)__builtin_amdgcn_readfirstlane((int)zlo_); args.ws = args0.ws + zoff_; args.out = args0.out + zoff_; \
    const int lane = tid & 63, wave = __builtin_amdgcn_readfirstlane(tid >> 6); (void)lane; (void)wave; \
    const float* MOD = (const float*)(args.ws + WS_MOD); const float* gnorm = (const float*)args.in[12]; \
    bf16_t* H = (bf16_t*)(args.ws + WS_H); bf16_t* Zb = (bf16_t*)(args.ws + WS_Z); bf16_t* OUTB = (bf16_t*)(args.ws + WS_OUTB); bf16_t* YB = (bf16_t*)(args.ws + WS_YB); \
    (void)MOD; (void)gnorm; (void)H; (void)Zb; (void)OUTB; (void)YB;
#define PH_END   if (ph + 1 < hi) xcd_barrier(bar); } ++ph;


template <int layer>
__device__ __forceinline__ void layer_phases(const Args& args0, LAS unsigned char* lds, const int tid0, const int bid0, const int G0, const int lo, const int hi, const XcdBarrier& bar) {
    constexpr int kind = layer % 3, jm = layer / 3;
    int ph = layer == 0 ? 2 : (layer == 1 ? 10 : (layer == 2 ? 17 : 25));
#define modL (MOD + (size_t)layer * 16 * 6 * D)
#define gnL (gnorm + (size_t)layer * 4 * D)
#define GEMM_CALL(LDA_, LDB_, K_, EPI_, SCHED_) pg8::gemm_phase<LDA_, LDB_, K_, EPI_, SCHED_, PG8_ALIGN, PG8_SP2>(lds + SCR_OFF, g, S, E, tid)
        if constexpr (kind == 0) {
            PH_BEGIN
                const bf16_t* W = (const bf16_t*)(args.ws + WS_WA_IN) + (size_t)jm * AINP * D;
                pg8::Gemm g{H, W}; typedef pg8::StaticOrder<128, 24> SO; SO S{G, bid}; typedef pg8::EpiGen<AINP, 0, 0, 0> EP; EP E{Zb};
                GEMM_CALL(D, D, D, EP, SO);
                pg8::skinny2<D, D, D>(H, W, Zb, AINP, 0, 192, 0, 0, 0, MP, lds + SCR_OFF, wave, lane, bid, G);
            PH_END
            PH_BEGIN
                mlstm_scan(args, lds, jm, tid, wave, lane, G, bid);
            PH_END
            PH_BEGIN
                mlstm_headnorm(args, jm, wave, lane, G, bid);
            PH_END
            PH_BEGIN
                const bf16_t* W = (const bf16_t*)(args.ws + WS_WA_OUT) + (size_t)jm * D * D;
                pg8::Gemm g{YB, W}; typedef pg8::StaticOrder<128, 8> SO; SO S{G, bid}; typedef pg8::EpiGen<D, 0, 0, 0> EP; EP E{OUTB};
                GEMM_CALL(D, D, D, EP, SO);
                pg8::skinny2<D, D, D>(YB, W, OUTB, D, 0, 64, 0, 0, 0, MP, lds + SCR_OFF, wave, lane, bid, G);
            PH_END
        } else if constexpr (kind == 1) {
            PH_BEGIN
                const bf16_t* W = (const bf16_t*)(args.ws + WS_WB_IN);
                pg8::Gemm g{H, W}; typedef pg8::StaticOrder<128, 24> SO; SO S{G, bid}; typedef pg8::EpiGen<4096, 16, 0, -2048> EP; EP E{Zb};
                GEMM_CALL(D, D, D, EP, SO);
                pg8::skinny2<D, D, D>(H, W, Zb, 4096, 64, 64, 0, 4096, 2048, MP, lds + SCR_OFF, wave, lane, bid, G);
            PH_END
            PH_BEGIN
                conv_pass(args, lds, tid, wave, lane, G, bid);
            PH_END
            PH_BEGIN
                const bf16_t* W = (const bf16_t*)(args.ws + WS_WB_OUT);
                pg8::Gemm g{YB, W}; typedef pg8::StaticOrder<128, 8> SO; SO S{G, bid}; typedef pg8::EpiGen<D, 0, 0, 0> EP; EP E{OUTB};
                GEMM_CALL(D, D, D, EP, SO);
                pg8::skinny2<D, D, D>(YB, W, OUTB, D, 0, 64, 0, 0, 0, MP, lds + SCR_OFF, wave, lane, bid, G);
            PH_END
        } else {
            PH_BEGIN
                pg8::Gemm g{H, (const bf16_t*)(args.ws + WS_S5W)}; pg8::S5aOrder S{G, bid};
                pg8::EpiS5a E{(float*)(args.ws + WS_Z)};
                GEMM_CALL(S5K, 512, 512, pg8::EpiS5a, pg8::S5aOrder);
            PH_END
            PH_BEGIN
                for (int it = bid; it < 256; it += G) { if (it < 128) s5_scan(args, it, tid); else s5_sample(args, lds, it - 128, wave, lane); }
            PH_END
            PH_BEGIN
                pg8::Gemm g{H, (const bf16_t*)(args.ws + WS_S5T)}; pg8::S5cOrder S{G, bid};
                pg8::EpiS5c E{(bf16_t*)(args.ws + WS_YB2)};
                GEMM_CALL(S5K, S5K, S5K, pg8::EpiS5c, pg8::S5cOrder);
            PH_END
            PH_BEGIN
                const bf16_t* W = (const bf16_t*)(args.ws + WS_WC_OUT);
                const bf16_t* Y2 = (const bf16_t*)(args.ws + WS_YB2);
                pg8::Gemm g{Y2, W}; typedef pg8::StaticOrder<128, 16> SO; SO S{G, bid}; typedef pg8::EpiGen<D, 16, 2, 0> EP; EP E{OUTB};
                GEMM_CALL(D, D, D, EP, SO);
                pg8::skinny2<D, D, D>(Y2, W, OUTB, D, 64, 0, 2, 0, 0, MP, lds + SCR_OFF, wave, lane, bid, G);
            PH_END
        }
        PH_BEGIN
            RowPass R{nullptr, nullptr, OUTB, gnL + 1 * D, modL + 2 * D, gnL + 2 * D, modL + 3 * D, modL + 4 * D, 0, nullptr, nullptr};
            row_pass<false>(args, R, lds, tid, wave, lane, G, bid);
        PH_END
        PH_BEGIN
            const bf16_t* W = (const bf16_t*)(args.ws + WS_WGU) + (size_t)layer * 2 * DFF * D;
            pg8::Gemm g{H, W}; typedef pg8::StaticOrder<128, 44> SO; SO S{G, bid}; typedef pg8::EpiGen<DFF, 44, 1, 0> EP; EP E{Zb};
            GEMM_CALL(D, D, D, EP, SO);
            pg8::skinny2<D, D, D>(H, W, Zb, DFF, 176, 0, 1, 0, 0, MP, lds + SCR_OFF, wave, lane, bid, G);
        PH_END
        PH_BEGIN
            const bf16_t* W = (const bf16_t*)(args.ws + WS_WDN) + (size_t)layer * D * DFF;
            pg8::Gemm g{Zb, W}; typedef pg8::StaticOrder<128, 8> SO; SO S{G, bid}; typedef pg8::EpiGen<D, 0, 0, 0> EP; EP E{OUTB};
            GEMM_CALL(DFF, DFF, DFF, EP, SO);
            pg8::skinny2<DFF, DFF, DFF>(Zb, W, OUTB, D, 0, 64, 0, 0, 0, MP, lds + SCR_OFF, wave, lane, bid, G);
        PH_END
        PH_BEGIN
            const int nl = layer + 1, nk = nl % 3;
            const float* modN = MOD + (size_t)nl * 16 * 6 * D;
            RowPass R{nullptr, nullptr, OUTB, gnL + 3 * D, modL + 5 * D, nl < DEPTH ? gnorm + (size_t)nl * 4 * D : nullptr, modN + 0 * D, modN + 1 * D,
                      nk == 0 ? 1 : (nk == 2 ? 2 : 0), (const float*)args.in[13] + (size_t)(nl / 3) * D * AIN + AINP, (const float*)args.in[14] + (nl / 3) * 8};
            row_pass<false>(args, R, lds, tid, wave, lane, G, bid);
        PH_END
    }
__global__ void __launch_bounds__(512, 2) mk_fwd(Args args0) {
    extern __shared__ __attribute__((aligned(16))) unsigned char lds_raw[];
    LAS unsigned char* lds = (LAS unsigned char*)lds_raw;
    const int tid0 = threadIdx.x, bid0 = blockIdx.x, G0 = gridDim.x;
    if (tid0 < 64) ((LAS unsigned*)(lds + LCTL_OFF))[tid0] = 0u;
    __syncthreads();
    unsigned* ctl = (unsigned*)(args0.ws + WS_CTL);
    XcdBarrier bar = xcd_barrier_post(ctl + 4096 + args0.li * XCD_BAR_WORDS, (volatile LAS unsigned*)(lds + LCTL_OFF));
    int ph = 0;
    const int lo = args0.ph_lo, hi = args0.ph_hi;
    PH_BEGIN
        if (bid < 64) { p0_s5_group(args, lds, bid, tid); p0_s5_group(args, lds, bid + 64, tid); }
        for (int task = bid - 64; task >= 0 && task < 192; task += G) p0_mod_task(args, lds, task, tid, wave, lane);
        p0_weights(args, lds, wave, lane, G, bid);
    PH_END
    PH_BEGIN
        RowPass R{(const float*)args.in[0], (const float*)args.in[1], nullptr, nullptr, nullptr, gnorm, MOD + 0 * D, MOD + 1 * D, 1, (const float*)args.in[13] + AINP, (const float*)args.in[14]};
        row_pass<true>(args, R, lds, tid, wave, lane, G, bid);
        p1_s5_tables(args, bid * 512 + tid, G * 512);
    PH_END

    layer_phases<0>(args0, lds, tid0, bid0, G0, lo, hi, bar);
    layer_phases<1>(args0, lds, tid0, bid0, G0, lo, hi, bar);
    layer_phases<2>(args0, lds, tid0, bid0, G0, lo, hi, bar);
    layer_phases<3>(args0, lds, tid0, bid0, G0, lo, hi, bar);
#undef GEMM_CALL
#undef PH_BEGIN
#undef PH_END
#undef modL
#undef gnL
}

extern "C" void kernel_launch(void* const* d_in, const int* in_sizes, int n_in, void* d_out, int out_size, void* d_ws, size_t ws_size, hipStream_t stream) {
    static int grid = 0;
    if (grid == 0) {
        if (n_in != 32 || (size_t)out_size != OUT_TOTAL || ws_size < WS_END) {
            fprintf(stderr, "kernel_launch: unexpected shapes: n_in %d out %d (want %zu) ws %zu (want >= %zu); nothing launched\n", n_in, out_size, (size_t)OUT_TOTAL, ws_size, (size_t)WS_END); grid = -1; return; }
        int dev = 0, cus = 0, per_cu = 0;
        if (hipGetDevice(&dev) != hipSuccess || hipDeviceGetAttribute(&cus, hipDeviceAttributeMultiprocessorCount, dev) != hipSuccess) { grid = -1; return; }
        if (hipFuncSetAttribute((const void*)mk_fwd, hipFuncAttributeMaxDynamicSharedMemorySize, LDS_BYTES) != hipSuccess) { fprintf(stderr, "kernel_launch: hipFuncSetAttribute failed\n"); grid = -1; return; }
        if (hipOccupancyMaxActiveBlocksPerMultiprocessor(&per_cu, (const void*)mk_fwd, 512, LDS_BYTES) != hipSuccess || per_cu < 1) { fprintf(stderr, "kernel_launch: occupancy query says %d\n", per_cu); }
        (void)hipGetLastError();
        grid = cus;
    }
    if (grid < 0) return;
    (void)hipMemsetAsync((char*)d_ws + WS_CTL, 0, CTL_ZERO_BYTES, stream);
    Args a{};
    for (int i = 0; i < 32; ++i) a.in[i] = d_in[i];
    a.out = (float*)d_out; a.ws = (unsigned char*)d_ws;
    constexpr int NPH = 2 + 8 + 7 + 8 + 8;
#ifdef DBG_STOP
    for (int p = 0; p < DBG_STOP; ++p) { a.ph_lo = p; a.ph_hi = p + 1; a.li = 0; hipLaunchKernelGGL(mk_fwd, dim3(grid), dim3(512), LDS_BYTES, stream, a); }
    (void)hipMemcpyAsync((char*)d_out, (char*)d_ws + (size_t)DBG_DUMP_OFF, (size_t)DBG_DUMP_BYTES, hipMemcpyDeviceToDevice, stream);
    return;
#endif
#if MK_N_LAUNCHES == 1
    a.ph_lo = 0; a.ph_hi = NPH; a.li = 0;
    hipLaunchKernelGGL(mk_fwd, dim3(grid), dim3(512), LDS_BYTES, stream, a);
#else
#ifndef DBG_REPMASK
#define DBG_REPMASK 0ull
#endif
    for (int p = 0; p < NPH; ++p) { const int nrep = ((DBG_REPMASK >> p) & 1ull) ? 2 : 1;
        for (int r = 0; r < nrep; ++r) { a.ph_lo = p; a.ph_hi = p + 1; a.li = 0; hipLaunchKernelGGL(mk_fwd, dim3(grid), dim3(512), LDS_BYTES, stream, a); } }
#endif
    const hipError_t le = hipPeekAtLastError();
    if (le != hipSuccess) fprintf(stderr, "kernel_launch: launch failed: %s\n", hipGetErrorName(le));
}
```

```cpp
#include <hip/hip_runtime.h>
#include <cstdio>
#include <cstdint>
#include <type_traits>

#ifndef MK_N_LAUNCHES
#define MK_N_LAUNCHES 1
#endif
#ifndef REP_GEMM
#define REP_GEMM 1
#endif
#ifndef REP_MIX
#define REP_MIX 1
#endif

#define LAS __attribute__((address_space(3)))
#define GAS __attribute__((address_space(1)))
typedef unsigned short bf16_t;
typedef short bf16x8 __attribute__((ext_vector_type(8)));
typedef short bf16x4 __attribute__((ext_vector_type(4)));
typedef float f32x4 __attribute__((ext_vector_type(4)));
typedef float f32x2 __attribute__((ext_vector_type(2)));
typedef unsigned u32x4 __attribute__((ext_vector_type(4)));
typedef unsigned u32x2 __attribute__((ext_vector_type(2)));

namespace pg8 {
constexpr int BM = 256, BK = 64, HALF = 128, HTB = HALF * BK * 2, STAGE_BYTES = 8 * HTB, NXCD = 8, WGM = 4;
__host__ __device__ __forceinline__ int lds_byte(int r, int c) { const int st = (r >> 4) * 2 + (c >> 5), rr = r & 15, cc = c & 31, ob = rr * 64 + cc * 2; return st * 1024 + (ob ^ (((ob >> 9) & 1) << 5)); }
__host__ __device__ __forceinline__ void stage_rc(int b, int& R, int& C) { const int st = b / 1024, sb = b % 1024, swz = sb ^ (((sb >> 9) & 1) << 5); R = (st >> 1) * 16 + swz / 64; C = (st & 1) * 32 + (swz % 64) / 2; }
__host__ __device__ __forceinline__ int perm32(int rho) { const int n = rho >> 4, i = rho & 15; return 8 * (i >> 2) + 4 * n + (i & 3); }

struct Unit { int pm, pn; };
struct Gemm { const bf16_t* A; const bf16_t* Bt; };

template <int nM, int nN> struct StaticOrder {
    static constexpr int nwg = nM * nN;
    int G, c;
    __device__ bool next(int i, Unit& u) const {
        const long L = (long)i * G + c; if (L >= nwg) return false;
        int wgid = (int)L; { const int q = nwg / NXCD, r = nwg % NXCD, xcd = wgid % NXCD, off = wgid / NXCD; wgid = (xcd < r ? xcd * (q + 1) : r * (q + 1) + (xcd - r) * q) + off; }
        const int nig = WGM * nN, gid = wgid / nig, fm = gid * WGM, gsz = (nM - fm) < WGM ? (nM - fm) : WGM;
        u.pm = fm + ((wgid % nig) % gsz); u.pn = (wgid % nig) / gsz; return true;
    }
};
struct S5cOrder {
    int G, c;
    __device__ bool next(int i, Unit& u) const { const long L = (long)i * G + c; if (L >= 1024) return false; const int g = (int)L >> 3, r = (int)L & 7; u.pm = g * 4 + (r >> 1); u.pn = g * 2 + (r & 1); return true; }
};
struct S5aOrder {
    int G, c;
    __device__ bool next(int i, Unit& u) const { const long L = (long)i * G + c; if (L >= 512) return false; u.pm = (int)L; u.pn = (int)L >> 2; return true; }
};

typedef __bf16 bf16v2_t __attribute__((ext_vector_type(2)));
__device__ __forceinline__ unsigned cvt_pk_bf16(float lo, float hi) { const f32x2 v = {lo, hi}; const bf16v2_t b = __builtin_convertvector(v, bf16v2_t); return __builtin_bit_cast(unsigned, b); }
__device__ __forceinline__ float fsig(float x) { return __builtin_amdgcn_rcpf(1.0f + __builtin_amdgcn_exp2f(-1.44269504f * x)); }

__device__ __forceinline__ u32x4 lane_xpose(const u32x4 w, const int src4) {
    u32x4 r; r.x = (unsigned)__builtin_amdgcn_ds_bpermute(src4, (int)w.x); r.y = (unsigned)__builtin_amdgcn_ds_bpermute(src4, (int)w.y); r.z = (unsigned)__builtin_amdgcn_ds_bpermute(src4, (int)w.z); r.w = (unsigned)__builtin_amdgcn_ds_bpermute(src4, (int)w.w); return r; }
template <int ldc, int mul_tiles, int act, int plain_coladd> struct EpiGen {
    static constexpr bool PERM = true;
    bf16_t* O;
    __device__ __forceinline__ void operator()(const f32x4 (&acc)[2][2][4][2], const Unit& u, int wr, int wc, int fr0, int fq0) const {
        const int src4 = 4 * ((fr0 & 3) * 16 + 4 * fq0 + (fr0 >> 2));
        const int fr = 4 * fq0 + (fr0 >> 2), fq = fr0 & 3;
        const int row0 = u.pm * BM + wr * 64 + fr;
        if (u.pn < mul_tiles) {
            const int col0 = u.pn * 128 + wc * 32 + 8 * fq;
#pragma unroll
            for (int ai = 0; ai < 2; ++ai)
#pragma unroll
                for (int m = 0; m < 4; ++m) {
                    bf16_t* rowp = O + (size_t)(row0 + ai * HALF + m * 16) * ldc + col0;
                    float v[8];
#pragma unroll
                    for (int n = 0; n < 2; ++n)
#pragma unroll
                        for (int e = 0; e < 4; ++e) {
                            const float a = acc[ai][0][m][n][e], b = acc[ai][1][m][n][e];
                            float r;
                            if (act == 0) r = a * b; else if (act == 1) r = a * fsig(a) * b; else r = a * fsig(b);
                            v[n * 4 + e] = r;
                        }
                    u32x4 w; w.x = cvt_pk_bf16(v[0], v[1]); w.y = cvt_pk_bf16(v[2], v[3]); w.z = cvt_pk_bf16(v[4], v[5]); w.w = cvt_pk_bf16(v[6], v[7]);
                    *(u32x4*)rowp = lane_xpose(w, src4);
                }
        } else {
            const int col0 = u.pn * BM + plain_coladd + wc * 32 + 8 * fq;
#pragma unroll
            for (int ai = 0; ai < 2; ++ai)
#pragma unroll
                for (int m = 0; m < 4; ++m) {
                    bf16_t* rowp = O + (size_t)(row0 + ai * HALF + m * 16) * ldc + col0;
#pragma unroll
                    for (int bj = 0; bj < 2; ++bj) {
                        const f32x4 v0 = acc[ai][bj][m][0], v1 = acc[ai][bj][m][1];
                        u32x4 w; w.x = cvt_pk_bf16(v0[0], v0[1]); w.y = cvt_pk_bf16(v0[2], v0[3]); w.z = cvt_pk_bf16(v1[0], v1[1]); w.w = cvt_pk_bf16(v1[2], v1[3]);
                        *(u32x4*)(rowp + bj * HALF) = lane_xpose(w, src4);
                    }
                }
        }
    }
};
struct EpiS5a {
    static constexpr bool PERM = false;
    float* XL;
    __device__ __forceinline__ void operator()(const f32x4 (&acc)[2][2][4][2], const Unit& u, int wr, int wc, int fr, int fq) const {
        const int row0 = u.pm * BM + wr * 64 + fr, col0 = wc * 32 + 4 * fq;
#pragma unroll
        for (int ai = 0; ai < 2; ++ai)
#pragma unroll
            for (int m = 0; m < 4; ++m) {
                float* rowp = XL + (size_t)(row0 + ai * HALF + m * 16) * 128 + col0;
#pragma unroll
                for (int n = 0; n < 2; ++n) *(f32x4*)(rowp + n * 16) = acc[ai][0][m][n];
            }
    }
};
struct EpiS5c {
    static constexpr bool PERM = true;
    bf16_t* Y;
    __device__ __forceinline__ void operator()(const f32x4 (&acc)[2][2][4][2], const Unit& u, int wr, int wc, int fr, int fq) const {
        const int g = u.pm >> 2, pml = u.pm & 3, pnl = u.pn & 1;
#pragma unroll
        for (int ai = 0; ai < 2; ++ai)
#pragma unroll
            for (int m = 0; m < 4; ++m) {
                const int inst = pml * 256 + ai * HALF + wr * 64 + m * 16 + fr;
                const int b = inst >> 7, c = inst & 127;
#pragma unroll
                for (int bj = 0; bj < 2; ++bj) {
                    const int tc = pnl * 256 + bj * HALF + wc * 32 + 8 * fq;
                    const int t = tc >> 4, p = tc & 15;
                    float v[8];
#pragma unroll
                    for (int n = 0; n < 2; ++n)
#pragma unroll
                        for (int e = 0; e < 4; ++e) {
                            const float x = acc[ai][bj][m][n][e];
                            const float uu = 0.7978845608f * (x + 0.044715f * x * x * x);
                            v[n * 4 + e] = x * fsig(2.0f * uu);
                        }
                    u32x4 w; w.x = cvt_pk_bf16(v[0], v[1]); w.y = cvt_pk_bf16(v[2], v[3]); w.z = cvt_pk_bf16(v[4], v[5]); w.w = cvt_pk_bf16(v[6], v[7]);
                    *(u32x4*)(Y + (size_t)(b * 4096 + c * 32 + t) * 2048 + g * 16 + p) = w;
                }
            }
    }
};

template <int LDA, int LDB, int K, class Epi, class Sched, bool ALIGN_EPI, bool SP2>
__device__ __forceinline__ void gemm_phase(LAS unsigned char* lds, const Gemm g, const Sched& S, const Epi& E, const int tid) {
    const int wid = __builtin_amdgcn_readfirstlane(tid >> 6), lane = tid & 63, wr = wid >> 2, wc = wid & 3, fr = lane & 15, fq = lane >> 4;
    constexpr int nt = K / BK;
    unsigned voffA[2], voffB[2];
#pragma unroll
    for (int i = 0; i < 2; ++i) { int R, C; stage_rc(tid * 16 + i * 8192, R, C); const int Rb = Epi::PERM ? ((R & ~31) + perm32(R & 31)) : R;
        voffA[i] = (unsigned)(R * LDA + C) * 2u; voffB[i] = (unsigned)(Rb * LDB + C) * 2u; }
    constexpr size_t kstep = (size_t)(BK * 2);
    constexpr size_t hstepA = (size_t)HALF * LDA * 2, hstepB = (size_t)HALF * LDB * 2;
    constexpr size_t tstepA = 2 * hstepA, tstepB = 2 * hstepB;
    const unsigned ldsw = (unsigned)wid * 1024u;
    const int aoff = lds_byte(wr * 64 + fr, fq * 8), boff = lds_byte(wc * 32 + fr, fq * 8);
#define PG8_SA(b, h) (((b) * 2 + (h)) * HTB)
#define PG8_SB(b, h) ((4 + (b) * 2 + (h)) * HTB)
#define PG8_STAGE(bufoff, gbase, voff) do { _Pragma("unroll") for (int _i = 0; _i < 2; ++_i) \
        __builtin_amdgcn_global_load_lds((const unsigned*)((const char*)(gbase) + (voff)[_i]), (LAS unsigned*)(lds + (bufoff) + ldsw + _i * 8192), 16, 0, 0); } while (0)
#define PG8_LDA(dst, b, h) do { _Pragma("unroll") for (int m = 0; m < 4; ++m) _Pragma("unroll") for (int k = 0; k < 2; ++k) dst[m][k] = *(const LAS bf16x8*)(lds + PG8_SA(b, h) + aoff + m * 2048 + k * 1024); } while (0)
#define PG8_LDB(dst, b, h) do { _Pragma("unroll") for (int n = 0; n < 2; ++n) _Pragma("unroll") for (int k = 0; k < 2; ++k) dst[n][k] = *(const LAS bf16x8*)(lds + PG8_SB(b, h) + boff + n * 2048 + k * 1024); } while (0)
#define PG8_MMA(ai, bj, At, Bt) do { __builtin_amdgcn_s_setprio(1); _Pragma("unroll") for (int m = 0; m < 4; ++m) _Pragma("unroll") for (int n = 0; n < 2; ++n) _Pragma("unroll") for (int k = 0; k < 2; ++k) \
        acc[ai][bj][m][n] = __builtin_amdgcn_mfma_f32_16x16x32_bf16(Bt[n][k], At[m][k], acc[ai][bj][m][n], 0, 0, 0); __builtin_amdgcn_s_setprio(0); } while (0)
#define PG8_WAIT_V(n) asm volatile("s_waitcnt vmcnt(" #n ")" ::: "memory")
#define PG8_WAIT_L(n) asm volatile("s_waitcnt lgkmcnt(" #n ")" ::: "memory")
#define PG8_BAR __builtin_amdgcn_s_barrier()
#define PG8_SCHED __builtin_amdgcn_sched_barrier(0)
    Unit cur, nxt; int ui = 0;
    if (!S.next(0, cur)) return;
    f32x4 acc[2][2][4][2];
#pragma unroll
    for (int a = 0; a < 2; ++a)
#pragma unroll
        for (int b = 0; b < 2; ++b)
#pragma unroll
            for (int m = 0; m < 4; ++m)
#pragma unroll
                for (int n = 0; n < 2; ++n) acc[a][b][m][n] = (f32x4){0.f, 0.f, 0.f, 0.f};
    bf16x8 At[4][2], B0[2][2], B1[2][2];
    const char* cA = (const char*)g.A + (size_t)cur.pm * tstepA; const char* cB = (const char*)g.Bt + (size_t)cur.pn * tstepB;
    if constexpr (SP2) {
        PG8_STAGE(PG8_SB(0, 0), cB, voffB); PG8_STAGE(PG8_SB(0, 1), cB + hstepB, voffB); PG8_STAGE(PG8_SA(0, 0), cA, voffA); PG8_STAGE(PG8_SA(0, 1), cA + hstepA, voffA);
        if (wr == 1) PG8_BAR;
        PG8_WAIT_V(2); PG8_BAR;
        PG8_STAGE(PG8_SB(1, 0), cB + kstep, voffB); PG8_STAGE(PG8_SA(1, 0), cA + kstep, voffA); PG8_STAGE(PG8_SB(1, 1), cB + hstepB + kstep, voffB);
        PG8_WAIT_V(6); PG8_BAR;
    } else {
        PG8_STAGE(PG8_SB(0, 0), cB, voffB); PG8_STAGE(PG8_SA(0, 0), cA, voffA); PG8_STAGE(PG8_SB(0, 1), cB + hstepB, voffB); PG8_STAGE(PG8_SA(0, 1), cA + hstepA, voffA);
        if (wr == 1) PG8_BAR;
        PG8_WAIT_V(4); PG8_BAR;
        PG8_STAGE(PG8_SB(1, 0), cB + kstep, voffB); PG8_STAGE(PG8_SA(1, 0), cA + kstep, voffA); PG8_STAGE(PG8_SB(1, 1), cB + hstepB + kstep, voffB);
        PG8_WAIT_V(6); PG8_BAR;
    }
    for (;;) {
        const bool has_next = S.next(ui + 1, nxt);
        const char* nA = has_next ? (const char*)g.A + (size_t)nxt.pm * tstepA : cA; const char* nB = has_next ? (const char*)g.Bt + (size_t)nxt.pn * tstepB : cB;
        for (int t = 0; t < nt; t += 2) {
            const bool last = (t == nt - 2);
            const char* a1 = cA + (size_t)(t + 1) * kstep;
            const char* a2 = last ? nA : cA + (size_t)(t + 2) * kstep; const char* b2 = last ? nB : cB + (size_t)(t + 2) * kstep;
            const char* a3 = a2 + kstep; const char* b3 = b2 + kstep;
            if constexpr (SP2) {
            PG8_LDB(B0, 0, 0); PG8_LDB(B1, 0, 1); PG8_SCHED; PG8_LDA(At, 0, 0); PG8_STAGE(PG8_SA(1, 1), a1 + hstepA, voffA);
            PG8_WAIT_V(8); PG8_WAIT_L(0); PG8_BAR; PG8_MMA(0, 0, At, B0); PG8_MMA(0, 1, At, B1); PG8_BAR; PG8_SCHED;
            PG8_LDA(At, 0, 1); PG8_STAGE(PG8_SB(0, 0), b2, voffB); PG8_STAGE(PG8_SB(0, 1), b2 + hstepB, voffB); PG8_STAGE(PG8_SA(0, 0), a2, voffA);
            PG8_WAIT_V(8); PG8_WAIT_L(0); PG8_BAR; PG8_MMA(1, 0, At, B0); PG8_MMA(1, 1, At, B1); PG8_BAR; PG8_SCHED;
            PG8_LDB(B0, 1, 0); PG8_LDB(B1, 1, 1); PG8_SCHED; PG8_LDA(At, 1, 0); PG8_STAGE(PG8_SA(0, 1), a2 + hstepA, voffA);
            PG8_WAIT_V(8); PG8_WAIT_L(0); PG8_BAR; PG8_MMA(0, 0, At, B0); PG8_MMA(0, 1, At, B1); PG8_BAR; PG8_SCHED;
            PG8_LDA(At, 1, 1); PG8_STAGE(PG8_SB(1, 0), b3, voffB); PG8_STAGE(PG8_SB(1, 1), b3 + hstepB, voffB); PG8_STAGE(PG8_SA(1, 0), a3, voffA);
            PG8_WAIT_V(8); PG8_WAIT_L(0); PG8_BAR; PG8_MMA(1, 0, At, B0); PG8_MMA(1, 1, At, B1); PG8_BAR; PG8_SCHED;
            } else {
            PG8_LDB(B0, 0, 0); PG8_SCHED; PG8_LDA(At, 0, 0); PG8_STAGE(PG8_SA(1, 1), a1 + hstepA, voffA);
            PG8_WAIT_L(8); PG8_BAR; PG8_WAIT_L(0); PG8_MMA(0, 0, At, B0); PG8_BAR; PG8_SCHED;
            PG8_LDB(B1, 0, 1); PG8_STAGE(PG8_SB(0, 0), b2, voffB);
            PG8_BAR; PG8_WAIT_L(0); PG8_MMA(0, 1, At, B1); PG8_BAR;
            PG8_LDA(At, 0, 1); PG8_STAGE(PG8_SA(0, 0), a2, voffA);
            PG8_BAR; PG8_WAIT_L(0); PG8_MMA(1, 0, At, B0); PG8_BAR; PG8_SCHED;
            PG8_STAGE(PG8_SB(0, 1), b2 + hstepB, voffB);
            PG8_WAIT_V(6); PG8_BAR; PG8_MMA(1, 1, At, B1); PG8_BAR;
            PG8_LDB(B0, 1, 0); PG8_SCHED; PG8_LDA(At, 1, 0); PG8_STAGE(PG8_SA(0, 1), a2 + hstepA, voffA);
            PG8_WAIT_L(8); PG8_BAR; PG8_WAIT_L(0); PG8_MMA(0, 0, At, B0); PG8_BAR; PG8_SCHED;
            PG8_LDB(B1, 1, 1); PG8_STAGE(PG8_SB(1, 0), b3, voffB);
            PG8_BAR; PG8_WAIT_L(0); PG8_MMA(0, 1, At, B1); PG8_BAR;
            PG8_LDA(At, 1, 1); PG8_STAGE(PG8_SA(1, 0), a3, voffA);
            PG8_BAR; PG8_WAIT_L(0); PG8_MMA(1, 0, At, B0); PG8_BAR; PG8_SCHED;
            PG8_STAGE(PG8_SB(1, 1), b3 + hstepB, voffB);
            PG8_WAIT_V(6); PG8_BAR; PG8_MMA(1, 1, At, B1); PG8_BAR;
            }
        }
        if constexpr (ALIGN_EPI) { if (wr == 0) PG8_BAR; }
        E(acc, cur, wr, wc, fr, fq);
        if (!has_next) break;
#pragma unroll
        for (int a = 0; a < 2; ++a)
#pragma unroll
            for (int b = 0; b < 2; ++b)
#pragma unroll
                for (int m = 0; m < 4; ++m)
#pragma unroll
                    for (int n = 0; n < 2; ++n) { typedef double f64x2_ __attribute__((ext_vector_type(2))); double d0_, d1_;
                        asm volatile("v_mov_b64 %0, 0" : "=v"(d0_)); asm volatile("v_mov_b64 %0, 0" : "=v"(d1_)); acc[a][b][m][n] = __builtin_bit_cast(f32x4, (f64x2_){d0_, d1_}); }
        cur = nxt; cA = nA; cB = nB; ++ui;
        if constexpr (ALIGN_EPI) { if (wr == 1) PG8_BAR; }
    }
    PG8_WAIT_V(0);
    if constexpr (!ALIGN_EPI) { if (wr == 0) PG8_BAR; }
    PG8_BAR;
#undef PG8_SA
#undef PG8_SB
#undef PG8_STAGE
#undef PG8_LDA
#undef PG8_LDB
#undef PG8_MMA
#undef PG8_WAIT_V
#undef PG8_WAIT_L
#undef PG8_BAR
#undef PG8_SCHED
}

template <int LDA, int LDB, int K>
__device__ __forceinline__ void skinny_rows(const bf16_t* A, const bf16_t* Bt, bf16_t* O, int ldc, int nu_mul, int nu_plain, int act, int plain_brow0, int plain_ocol0, int row_base,
                                            int wave, int lane, int bid, int G) {
    const int fr = lane & 15, fq = lane >> 4;
    const bf16_t* ap = A + (size_t)(row_base + 16 * wave + fr) * LDA + 8 * fq;
    for (int c = bid; c < nu_mul + nu_plain; c += G) {
        const bool mul = c < nu_mul;
        const int cc = mul ? c : c - nu_mul;
        const int brow = mul ? (((16 * cc) >> 7) << 8) + ((16 * cc) & 127) : plain_brow0 + 16 * cc;
        const int ocol = mul ? 16 * cc : plain_ocol0 + 16 * cc;
        const bf16_t* bp0 = Bt + (size_t)(brow + fr) * LDB + 8 * fq;
        const bf16_t* bp1 = bp0 + (size_t)128 * LDB;
        f32x4 acc0 = (f32x4){0.f, 0.f, 0.f, 0.f}, acc1 = (f32x4){0.f, 0.f, 0.f, 0.f};
        if (mul) {
            bf16x8 av[4], b0[4], b1[4], an[4], b0n[4], b1n[4];
#pragma unroll
            for (int i = 0; i < 4; ++i) { av[i] = *(const bf16x8*)(ap + 32 * i); b0[i] = *(const bf16x8*)(bp0 + 32 * i); b1[i] = *(const bf16x8*)(bp1 + 32 * i); }
            for (int k0 = 0; k0 < K; k0 += 128) {
                const int kn = (k0 + 128 < K) ? k0 + 128 : k0;
#pragma unroll
                for (int i = 0; i < 4; ++i) { an[i] = *(const bf16x8*)(ap + kn + 32 * i); b0n[i] = *(const bf16x8*)(bp0 + kn + 32 * i); b1n[i] = *(const bf16x8*)(bp1 + kn + 32 * i); }
#pragma unroll
                for (int i = 0; i < 4; ++i) { acc0 = __builtin_amdgcn_mfma_f32_16x16x32_bf16(b0[i], av[i], acc0, 0, 0, 0); acc1 = __builtin_amdgcn_mfma_f32_16x16x32_bf16(b1[i], av[i], acc1, 0, 0, 0); }
#pragma unroll
                for (int i = 0; i < 4; ++i) { av[i] = an[i]; b0[i] = b0n[i]; b1[i] = b1n[i]; }
            }
        } else {
            bf16x8 av[8], b0[8], an[8], b0n[8];
#pragma unroll
            for (int i = 0; i < 8; ++i) { av[i] = *(const bf16x8*)(ap + 32 * i); b0[i] = *(const bf16x8*)(bp0 + 32 * i); }
            for (int k0 = 0; k0 < K; k0 += 256) {
                const int kn = (k0 + 256 < K) ? k0 + 256 : k0;
#pragma unroll
                for (int i = 0; i < 8; ++i) { an[i] = *(const bf16x8*)(ap + kn + 32 * i); b0n[i] = *(const bf16x8*)(bp0 + kn + 32 * i); }
#pragma unroll
                for (int i = 0; i < 8; ++i) acc0 = __builtin_amdgcn_mfma_f32_16x16x32_bf16(b0[i], av[i], acc0, 0, 0, 0);
#pragma unroll
                for (int i = 0; i < 8; ++i) { av[i] = an[i]; b0[i] = b0n[i]; }
            }
        }
        float v[4];
#pragma unroll
        for (int e = 0; e < 4; ++e) { const float x = acc0[e], y = acc1[e]; v[e] = !mul ? x : (act == 0 ? x * y : (act == 1 ? x * fsig(x) * y : x * fsig(y))); }
        u32x2 w; w.x = cvt_pk_bf16(v[0], v[1]); w.y = cvt_pk_bf16(v[2], v[3]);
        *(u32x2*)(O + (size_t)(row_base + 16 * wave + fr) * ldc + ocol + 4 * fq) = w;
    }
}

template <int NT, int LDA, int LDB, int KS>
__device__ __forceinline__ void skinny_kslice(const bf16_t* ap, const bf16_t* bp, f32x4 (&acc)[4][4], const int xsrc) {
    constexpr int NG = KS / 64;
    bf16x8 a0[4][2], b0[NT][2], a1[4][2], b1[NT][2];
#define SK_LOAD(g_, av_, bv_) do { const int ko_ = 64 * (g_); \
        _Pragma("unroll") for (int rb = 0; rb < 4; ++rb) _Pragma("unroll") for (int ks = 0; ks < 2; ++ks) av_[rb][ks] = *(const bf16x8*)(ap + (size_t)rb * 16 * LDA + ko_ + 32 * ks); \
        _Pragma("unroll") for (int t = 0; t < NT; ++t) _Pragma("unroll") for (int ks = 0; ks < 2; ++ks) bv_[t][ks] = *(const bf16x8*)(bp + (size_t)(NT == 4 ? (t >> 1) * 128 + (t & 1) * 16 : t * 16) * LDB + ko_ + 32 * ks); } while (0)
#define SK_MMA(av_, bv_) do { _Pragma("unroll") for (int rb = 0; rb < 4; ++rb) _Pragma("unroll") for (int t = 0; t < NT; ++t) _Pragma("unroll") for (int ks = 0; ks < 2; ++ks) \
        acc[rb][t] = __builtin_amdgcn_mfma_f32_16x16x32_bf16(bv_[t][ks], av_[rb][ks], acc[rb][t], 0, 0, 0); } while (0)
#define SK_XP1(v_) do { u32x4 t_ = __builtin_bit_cast(u32x4, v_); t_ = lane_xpose(t_, xsrc); v_ = __builtin_bit_cast(bf16x8, t_); } while (0)
#define SK_XP(av_, bv_) do { _Pragma("unroll") for (int rb = 0; rb < 4; ++rb) _Pragma("unroll") for (int ks = 0; ks < 2; ++ks) SK_XP1(av_[rb][ks]); \
        _Pragma("unroll") for (int t = 0; t < NT; ++t) _Pragma("unroll") for (int ks = 0; ks < 2; ++ks) SK_XP1(bv_[t][ks]); } while (0)
    SK_LOAD(0, a0, b0);
    for (int g = 0; g < NG; g += 2) {
        const int g1 = (g + 1 < NG) ? g + 1 : g, g2 = (g + 2 < NG) ? g + 2 : g;
        SK_LOAD(g1, a1, b1); __builtin_amdgcn_sched_barrier(0);
        SK_XP(a0, b0); SK_MMA(a0, b0); __builtin_amdgcn_sched_barrier(0);
        SK_LOAD(g2, a0, b0); __builtin_amdgcn_sched_barrier(0);
        if (g + 1 < NG) { SK_XP(a1, b1); SK_MMA(a1, b1); }
        __builtin_amdgcn_sched_barrier(0);
    }
#undef SK_LOAD
#undef SK_MMA
#undef SK_XP
#undef SK_XP1
}
template <int LDA, int LDB, int K>
__device__ __forceinline__ void skinny2(const bf16_t* A, const bf16_t* Bt, bf16_t* O, int ldc, int ng_mul, int ng_plain, int act, int plain_brow0, int plain_ocol0, int row_base,
                                        LAS unsigned char* lds, int wave, int lane, int bid, int G) {
    constexpr int KS = K / 8;
    const int fr = lane & 15, fq = lane >> 4;
    LAS f32x4* red = (LAS f32x4*)lds;
    for (int c = bid; c < 2 * (ng_mul + ng_plain); c += G) {
        const int half = c & 1, cg = c >> 1; const bool mul = cg < ng_mul; const int oc0 = 32 * (mul ? cg : cg - ng_mul);
        const int brow = mul ? ((oc0 >> 7) << 8) + (oc0 & 127) : plain_brow0 + oc0;
        const int ocol = mul ? oc0 : plain_ocol0 + oc0;
        const int frl = 4 * fq + (fr >> 2), fql = fr & 3;
        const int xsrc = 4 * ((fr >> 2) * 16 + (fr & 3) * 4 + fq);
        const bf16_t* ap = A + (size_t)(row_base + 64 * half + frl) * LDA + wave * KS + 8 * fql;
        const bf16_t* bp = Bt + (size_t)(brow + frl) * LDB + wave * KS + 8 * fql;
        f32x4 acc[4][4];
#pragma unroll
        for (int rb = 0; rb < 4; ++rb)
#pragma unroll
            for (int t = 0; t < 4; ++t) acc[rb][t] = (f32x4){0.f, 0.f, 0.f, 0.f};
        if (mul) skinny_kslice<4, LDA, LDB, KS>(ap, bp, acc, xsrc); else skinny_kslice<2, LDA, LDB, KS>(ap, bp, acc, xsrc);
#pragma unroll
        for (int rb = 0; rb < 4; ++rb)
#pragma unroll
            for (int t = 0; t < 4; ++t) red[((wave * 4 + rb) * 4 + t) * 64 + lane] = acc[rb][t];
        asm volatile("s_waitcnt lgkmcnt(0)" ::: "memory"); __builtin_amdgcn_s_barrier(); asm volatile("" ::: "memory");
        const int rrb = wave & 3, j = wave >> 2;
        f32x4 va = (f32x4){0.f, 0.f, 0.f, 0.f}, vb = (f32x4){0.f, 0.f, 0.f, 0.f};
#pragma unroll
        for (int w2 = 0; w2 < 8; ++w2) { va += red[((w2 * 4 + rrb) * 4 + j) * 64 + lane]; vb += red[((w2 * 4 + rrb) * 4 + 2 + j) * 64 + lane]; }
        float v[4];
#pragma unroll
        for (int e = 0; e < 4; ++e) { const float x = va[e], y = vb[e]; v[e] = !mul ? x : (act == 0 ? x * y : (act == 1 ? x * fsig(x) * y : x * fsig(y))); }
        u32x2 w; w.x = cvt_pk_bf16(v[0], v[1]); w.y = cvt_pk_bf16(v[2], v[3]);
        *(u32x2*)(O + (size_t)(row_base + 64 * half + 16 * rrb + fr) * ldc + ocol + 16 * j + 4 * fq) = w;
        asm volatile("s_waitcnt lgkmcnt(0)" ::: "memory"); __builtin_amdgcn_s_barrier(); asm volatile("" ::: "memory");
    }
}
}

#ifndef PG8_SP2
#define PG8_SP2 true
#endif
#ifndef PG8_ALIGN
#define PG8_ALIGN true
#endif

constexpr int D = 2048, DFF = 5632, NBATCH = 8, SEQ = 4096, DSEQ = 16, DEPTH = 4;
constexpr int MP = NBATCH * SEQ;
constexpr int MS = NBATCH * DSEQ;
constexpr int MR = MP + MS;
constexpr int MPAD = 33024;
constexpr int AH = 4, ADK = 256, ADV = 512, AIN = 6152, AINP = 6144;
constexpr int S5G = 128, S5P = 16, S5N = 64, S5L = 32, S5K = 640;
constexpr float EPS = 1e-6f;

constexpr size_t O_Y = 0;
constexpr size_t O_PC = (size_t)MR * D;
constexpr size_t SZ_C = (size_t)2 * 8 * 4 * 256 * 512, SZ_N = 2 * 8 * 4 * 256, SZ_M = 2 * 8 * 4, SZ_CONV = 8 * 2 * 2048, SZ_S5 = 8 * 128 * 64;
constexpr size_t O_PN = O_PC + SZ_C, O_PM = O_PN + SZ_N, O_PCONV = O_PM + SZ_M, O_PRE = O_PCONV + SZ_CONV, O_PIM = O_PRE + SZ_S5;
constexpr size_t O_SC = O_PIM + SZ_S5, O_SN = O_SC + SZ_C, O_SM = O_SN + SZ_N, O_SCONV = O_SM + SZ_M, O_SRE = O_SCONV + SZ_CONV, O_SIM = O_SRE + SZ_S5;
constexpr size_t OUT_TOTAL = O_SIM + SZ_S5;

constexpr size_t MiB = 1u << 20;
constexpr size_t WS_CTL = 0, CTL_ZERO_BYTES = 1 * MiB;
constexpr size_t WS_MOD = 1 * MiB;
constexpr size_t WS_GT = 4 * MiB;
constexpr size_t WS_DEN = 6 * MiB;
constexpr size_t WS_MT = 7 * MiB;
constexpr size_t WS_HS = 8 * MiB;
constexpr size_t WS_KD = 9 * MiB;
constexpr size_t WS_PW = 13 * MiB;
constexpr size_t WS_COEF = 16 * MiB;
constexpr size_t WS_PWT = 17 * MiB;
constexpr size_t WS_WA_IN = 20 * MiB, WS_WA_OUT = 68 * MiB, WS_WB_IN = 84 * MiB, WS_WB_OUT = 108 * MiB, WS_WC_OUT = 116 * MiB, WS_WGU = 132 * MiB, WS_WDN = 308 * MiB;
constexpr size_t WS_S5T = 396 * MiB;
constexpr size_t WS_S5W = 476 * MiB;
constexpr size_t WS_H = 508 * MiB;
constexpr size_t WS_Z = 668 * MiB;
constexpr size_t WS_OUTB = 1055 * MiB;
constexpr size_t WS_XB = 1184 * MiB;
constexpr size_t WS_YB = WS_H;
constexpr size_t WS_YB2 = WS_Z + 128 * MiB;
constexpr size_t WS_END = 1313 * MiB;

constexpr int LDS_BYTES = 147456;
constexpr int SCR_OFF = 0;
constexpr int LCTL_OFF = LDS_BYTES - 256;

#define LDS_WAIT() asm volatile("s_waitcnt lgkmcnt(0)" ::: "memory")
#define LBAR() do { asm volatile("s_waitcnt lgkmcnt(0)" ::: "memory"); __builtin_amdgcn_s_barrier(); asm volatile("" ::: "memory"); } while (0)

#define XB_TMO      128
#define XB_XCNT(j)  (256  + 64 * (j))
#define XB_XSUB(j)  (1280 + 64 * (j))
#define XB_XGEN(j)  (2304 + 64 * (j))
#define XB_TOP      3328
#define XB_TOPGEN   3392
#define XCD_BAR_WORDS 3456
#define XB_SPIN_CAP (1u << 22)

__device__ __forceinline__ unsigned xb_ld(unsigned* p)              { return __hip_atomic_load(p, __ATOMIC_RELAXED, __HIP_MEMORY_SCOPE_AGENT); }
__device__ __forceinline__ unsigned xb_add(unsigned* p, unsigned v) { return __hip_atomic_fetch_add(p, v, __ATOMIC_RELAXED, __HIP_MEMORY_SCOPE_AGENT); }
__device__ __forceinline__ unsigned xb_xcc_id() { return (unsigned)__builtin_amdgcn_s_getreg((3 << 11) | 20) & 0xFu; }
#define XB_SPIN(cond, bar) do { unsigned _sp = 0; while (cond) { __builtin_amdgcn_s_sleep(1); \
    if ((++_sp & 255u) == 0u) { if (xb_ld(&(bar)[XB_TMO])) break; if (_sp > XB_SPIN_CAP) { atomicAdd(&(bar)[XB_TMO], 1u); break; } } } } while (0)

struct XcdBarrier { unsigned* bar; unsigned x; volatile LAS unsigned* st; };

__device__ __forceinline__ XcdBarrier xcd_barrier_post(unsigned* bar, volatile LAS unsigned* st) {
    XcdBarrier b; b.bar = bar; b.x = xb_xcc_id(); b.st = st;
    if (threadIdx.x == 0) (void)xb_add(&bar[XB_XCNT(b.x)], 1u);
    return b;
}
__device__ __forceinline__ void xcd_barrier_complete(unsigned* bar, unsigned x, unsigned& nloc, unsigned& nx) {
    const unsigned G = gridDim.x * gridDim.y * gridDim.z;
    unsigned sum, cnt, mine, sp = 0u;
    for (;;) {
        sum = 0u; cnt = 0u; mine = 0u;
#pragma unroll
        for (unsigned j = 0; j < 16; ++j) { const unsigned c = xb_ld(&bar[XB_XCNT(j)]); sum += c; cnt += (c > 0u) ? 1u : 0u; mine = (j == x) ? c : mine; }
        if (sum == G) break;
        __builtin_amdgcn_s_sleep(1);
        if ((++sp & 255u) == 0u) { if (xb_ld(&bar[XB_TMO])) break; if (sp > XB_SPIN_CAP) { atomicAdd(&bar[XB_TMO], 1u); break; } }
    }
    nloc = mine > 0u ? mine : 1u; nx = cnt > 0u ? cnt : 1u;
}
__device__ __forceinline__ void xcd_barrier(const XcdBarrier& b) {
    asm volatile("s_waitcnt vmcnt(0)" ::: "memory");
    __syncthreads();
    if (threadIdx.x == 0) {
        unsigned* bar = b.bar;
        __builtin_amdgcn_s_waitcnt(0);
        unsigned nloc = b.st[0], nx = b.st[1];
        if (nloc == 0u) { xcd_barrier_complete(bar, b.x, nloc, nx); b.st[0] = nloc; b.st[1] = nx; }
        const unsigned old = xb_add(&bar[XB_XSUB(b.x)], 1u);
        const unsigned gen = old / nloc;
        if (old + 1u == (gen + 1u) * nloc) {
            __builtin_amdgcn_fence(__ATOMIC_RELEASE, "agent");
            asm volatile("s_waitcnt vmcnt(0)" ::: "memory");
            const unsigned og = xb_add(&bar[XB_TOP], 1u);
            const unsigned tg = og / nx;
            if (og + 1u == (tg + 1u) * nx) xb_add(&bar[XB_TOPGEN], 1u);
            else XB_SPIN(xb_ld(&bar[XB_TOPGEN]) == tg, bar);
            __builtin_amdgcn_fence(__ATOMIC_ACQUIRE, "agent");
            xb_add(&bar[XB_XGEN(b.x)], 1u);
            asm volatile("s_waitcnt vmcnt(0)" ::: "memory");
        } else {
            XB_SPIN(xb_ld(&bar[XB_XGEN(b.x)]) == gen, bar);
            __builtin_amdgcn_fence(__ATOMIC_ACQUIRE, "agent");
            asm volatile("s_waitcnt vmcnt(0)" ::: "memory");
        }
    }
    __syncthreads();
}

struct Args { const void* in[32]; float* out; unsigned char* ws; int ph_lo, ph_hi, li, pad; };


__device__ __forceinline__ float wave_sum(float v) {
#pragma unroll
    for (int o = 1; o < 64; o <<= 1) v += __shfl_xor(v, o);
    return v;
}
__device__ __forceinline__ float bf2f(unsigned short b) { return __uint_as_float((unsigned)b << 16); }
__device__ __forceinline__ float bflo(unsigned w) { return __uint_as_float(w << 16); }
__device__ __forceinline__ float bfhi(unsigned w) { return __uint_as_float(w & 0xffff0000u); }
__device__ __forceinline__ unsigned pk2(float lo, float hi) { return pg8::cvt_pk_bf16(lo, hi); }
__device__ __forceinline__ float fsig(float x) { return __builtin_amdgcn_rcpf(1.0f + __builtin_amdgcn_exp2f(-1.44269504f * x)); }

__device__ __forceinline__ void tr_item(const float* W, int ldw, int k0, int n0, bf16_t* WT, int Kd, int drow0, float scale, LAS float* scr, int lane) {
    float wv[32];
#pragma unroll
    for (int i = 0; i < 32; ++i) wv[i] = W[(size_t)(k0 + 2 * i + (lane >> 5)) * ldw + n0 + (lane & 31)];
#pragma unroll
    for (int i = 0; i < 32; ++i) scr[(2 * i + (lane >> 5)) * 33 + (lane & 31)] = wv[i] * scale;
    LDS_WAIT(); asm volatile("" ::: "memory");
    const int c = lane & 7;
#pragma unroll
    for (int j = 0; j < 4; ++j) { const int n = (lane >> 3) + 8 * j; const LAS float* s = scr + (8 * c) * 33 + n;
        u32x4 o; o.x = pk2(s[0 * 33], s[1 * 33]); o.y = pk2(s[2 * 33], s[3 * 33]); o.z = pk2(s[4 * 33], s[5 * 33]); o.w = pk2(s[6 * 33], s[7 * 33]);
        *(u32x4*)(WT + (size_t)(drow0 + n) * Kd + k0 + 8 * c) = o; }
    LDS_WAIT(); asm volatile("" ::: "memory");
}
__device__ __forceinline__ int map_pair(int c, int second) { return ((c >> 7) << 8) + (second ? 128 : 0) + (c & 127); }

__device__ __forceinline__ void p0_weights(const Args& a, LAS unsigned char* lds, int wave, int lane, int G, int bid) {
    LAS float* scr = (LAS float*)(lds + SCR_OFF + wave * 8448);
    const int nslot = bid < 64 ? 3 : 2, slot0 = bid < 64 ? 3 * bid : 192 + 2 * (bid - 64), NSLOT = (G > 64 ? 192 + 2 * (G - 64) : 3 * G) * 8;
    const float* wA_in = (const float*)a.in[13]; const float* wA_out = (const float*)a.in[16]; const float* wB_in = (const float*)a.in[17]; const float* wB_out = (const float*)a.in[19];
    const float* wC_out = (const float*)a.in[28]; const float* wg = (const float*)a.in[29]; const float* wu = (const float*)a.in[30]; const float* wd = (const float*)a.in[31];
    bf16_t* WA_IN = (bf16_t*)(a.ws + WS_WA_IN); bf16_t* WA_OUT = (bf16_t*)(a.ws + WS_WA_OUT); bf16_t* WB_IN = (bf16_t*)(a.ws + WS_WB_IN); bf16_t* WB_OUT = (bf16_t*)(a.ws + WS_WB_OUT);
    bf16_t* WC_OUT = (bf16_t*)(a.ws + WS_WC_OUT); bf16_t* WGU = (bf16_t*)(a.ws + WS_WGU); bf16_t* WDN = (bf16_t*)(a.ws + WS_WDN);
    constexpr int I_AIN = 32 * 192, I_AOUT = 32 * 64, I_BIN = 32 * 192, I_BOUT = 32 * 64, I_COUT = 32 * 128, I_G = 32 * 176, I_DN = 88 * 64;
    constexpr int NITEMS = 2 * I_AIN + 2 * I_AOUT + I_BIN + I_BOUT + I_COUT + 4 * I_G + 4 * I_G + 4 * I_DN;
    for (int sl = 0; sl < nslot; ++sl)
    for (int it = (slot0 + sl) * 8 + wave; it < NITEMS; it += NSLOT) {
        int r = it;
        if (r < 2 * I_AIN) { const int j = r / I_AIN; r -= j * I_AIN; const int kb = r / 192, nb = r % 192; const int n0 = nb * 32;
            tr_item(wA_in + (size_t)j * D * AIN, AIN, kb * 64, n0, WA_IN + (size_t)j * AINP * D, D, n0, n0 < 1024 ? 0.0625f : 1.0f, scr, lane); continue; }
        r -= 2 * I_AIN;
        if (r < 2 * I_AOUT) { const int j = r / I_AOUT; r -= j * I_AOUT; const int kb = r / 64, nb = r % 64;
            tr_item(wA_out + (size_t)j * D * D, D, kb * 64, nb * 32, WA_OUT + (size_t)j * D * D, D, nb * 32, 1.0f, scr, lane); continue; }
        r -= 2 * I_AOUT;
        if (r < I_BIN) { const int kb = r / 192, nb = r % 192; const int n0 = nb * 32;
            const int drow = n0 < 2048 ? 4096 + n0 : (n0 < 4096 ? map_pair(n0 - 2048, 0) : map_pair(n0 - 4096, 1));
            tr_item(wB_in, 6144, kb * 64, n0, WB_IN, D, drow, 1.0f, scr, lane); continue; }
        r -= I_BIN;
        if (r < I_BOUT) { const int kb = r / 64, nb = r % 64; tr_item(wB_out, D, kb * 64, nb * 32, WB_OUT, D, nb * 32, 1.0f, scr, lane); continue; }
        r -= I_BOUT;
        if (r < I_COUT) { const int kb = r / 128, nb = r % 128; const int n0 = nb * 32;
            const int drow = n0 < 2048 ? map_pair(n0, 0) : map_pair(n0 - 2048, 1);
            tr_item(wC_out, 4096, kb * 64, n0, WC_OUT, D, drow, 1.0f, scr, lane); continue; }
        r -= I_COUT;
        if (r < 4 * I_G) { const int i = r / I_G; r -= i * I_G; const int kb = r / 176, nb = r % 176;
            tr_item(wg + (size_t)i * D * DFF, DFF, kb * 64, nb * 32, WGU + (size_t)i * 2 * DFF * D, D, map_pair(nb * 32, 0), 1.0f, scr, lane); continue; }
        r -= 4 * I_G;
        if (r < 4 * I_G) { const int i = r / I_G; r -= i * I_G; const int kb = r / 176, nb = r % 176;
            tr_item(wu + (size_t)i * D * DFF, DFF, kb * 64, nb * 32, WGU + (size_t)i * 2 * DFF * D, D, map_pair(nb * 32, 1), 1.0f, scr, lane); continue; }
        r -= 4 * I_G;
        { const int i = r / I_DN; r -= i * I_DN; const int kb = r / 64, nb = r % 64;
            tr_item(wd + (size_t)i * DFF * D, D, kb * 64, nb * 32, WDN + (size_t)i * D * DFF, DFF, nb * 32, 1.0f, scr, lane); }
    }
}

__device__ __forceinline__ void p0_mod_task(const Args& a, LAS unsigned char* lds, int task, int tid, int wave, int lane) {
    const float* cP = (const float*)a.in[8]; const float* cS = (const float*)a.in[9]; const float* w_mod = (const float*)a.in[10]; const float* b_mod = (const float*)a.in[11];
    float* MOD = (float*)(a.ws + WS_MOD);
    const int i = task / 48, cb = task % 48;
    LAS float* s = (LAS float*)(lds + SCR_OFF);
    for (int e = tid; e < 2048 * 16; e += 512) { const int k = e >> 4, r = e & 15; const float c = r < 8 ? cP[r * D + k] : cS[(r - 8) * D + k]; s[e] = c * fsig(c); }
    LBAR();
    f32x4 acc[16];
#pragma unroll
    for (int r = 0; r < 16; ++r) acc[r] = (f32x4){0.f, 0.f, 0.f, 0.f};
    const int n = cb * 256 + 4 * lane;
    const float* wp = w_mod + ((size_t)i * D + wave * 256) * (6 * D) + n;
#pragma unroll 4
    for (int kk = 0; kk < 256; ++kk) {
        const f32x4 w = *(const f32x4*)(wp + (size_t)kk * (6 * D));
        const LAS f32x4* sp = (const LAS f32x4*)(s + (wave * 256 + kk) * 16);
        const f32x4 s0 = sp[0], s1 = sp[1], s2 = sp[2], s3 = sp[3];
        acc[0] += s0[0] * w; acc[1] += s0[1] * w; acc[2] += s0[2] * w; acc[3] += s0[3] * w;
        acc[4] += s1[0] * w; acc[5] += s1[1] * w; acc[6] += s1[2] * w; acc[7] += s1[3] * w;
        acc[8] += s2[0] * w; acc[9] += s2[1] * w; acc[10] += s2[2] * w; acc[11] += s2[3] * w;
        acc[12] += s3[0] * w; acc[13] += s3[1] * w; acc[14] += s3[2] * w; acc[15] += s3[3] * w;
    }
    LBAR();
    LAS float* red = (LAS float*)(lds + SCR_OFF);
#pragma unroll
    for (int r = 0; r < 16; ++r) *(LAS f32x4*)(red + (wave * 16 + r) * 256 + 4 * lane) = acc[r];
    LBAR();
    for (int e = tid; e < 16 * 256; e += 512) { const int r = e >> 8, c = e & 255; float v = b_mod[i * 6 * D + cb * 256 + c];
#pragma unroll
        for (int w = 0; w < 8; ++w) v += red[(w * 16 + r) * 256 + c];
        MOD[((size_t)i * 16 + r) * (6 * D) + cb * 256 + c] = v; }
    LBAR();
}


__device__ __forceinline__ void dsincos(double x, double& sn, double& cs) {
    const double kq = rint(x * 0.63661977236758134308);
    const double r = (x - kq * 1.57079632673412561417e+00) - kq * 6.07710050650619224932e-11;
    const int q = (int)((long long)kq & 3);
    const double r2 = r * r;
    const double ps = r + r * r2 * (-1.66666666666666324348e-01 + r2 * (8.33333333332248946124e-03 + r2 * (-1.98412698298579493134e-04 + r2 * (2.75573137070700676789e-06 + r2 * (-2.50507602534068634195e-08 + r2 * 1.58969099521155010221e-10)))));
    const double pc = 1.0 - 0.5 * r2 + r2 * r2 * (4.16666666666666019037e-02 + r2 * (-1.38888888888741095749e-03 + r2 * (2.48015872894767294178e-05 + r2 * (-2.75573143513906633035e-07 + r2 * (2.08757232129817482790e-09 + r2 * -1.13596475577881948265e-11)))));
    sn = (q == 0) ? ps : (q == 1) ? pc : (q == 2) ? -ps : -pc;
    cs = (q == 0) ? pc : (q == 1) ? -ps : (q == 2) ? -pc : ps;
}
__device__ __forceinline__ void p0_s5_group(const Args& a, LAS unsigned char* lds, int g, int tid) {
    const float* A_re = (const float*)a.in[20]; const float* A_im = (const float*)a.in[21]; const float* B_re = (const float*)a.in[22]; const float* B_im = (const float*)a.in[23];
    const float* C_re = (const float*)a.in[24]; const float* C_im = (const float*)a.in[25]; const float* Dsk = (const float*)a.in[26]; const float* log_dt = (const float*)a.in[27];
    f32x2* PW = (f32x2*)(a.ws + WS_PW); f32x2* COEF = (f32x2*)(a.ws + WS_COEF); float* KD = (float*)(a.ws + WS_KD);
    LAS f32x2* pw = (LAS f32x2*)(lds + SCR_OFF);
    LAS f32x2* cf = (LAS f32x2*)(lds + SCR_OFF + 64 * 33 * 8);
    LAS f32x2* bb = (LAS f32x2*)(lds + SCR_OFF + 64 * 33 * 8 + 512);
    const double dt = exp((double)log_dt[g]);
    for (int e = tid; e < 64 * 33; e += 512) {
        const int n = e / 33, d = e % 33;
        const double lr = (double)A_re[g * 64 + n], li = (double)A_im[g * 64 + n];
        const double mag = exp(lr * dt * (double)d), ang = li * dt * (double)d;
        double sn, cs; dsincos(ang, sn, cs);
        const f32x2 v = {(float)(mag * cs), (float)(mag * sn)};
        pw[n * 33 + d] = v; PW[((size_t)g * 64 + n) * 33 + d] = v; ((f32x2*)(a.ws + WS_PWT))[((size_t)g * 33 + d) * 64 + n] = v;
        if (d == 1) { const double ar = mag * cs, ai = mag * sn, nr = ar - 1.0, den = lr * lr + li * li;
            const f32x2 c = {(float)((nr * lr + ai * li) / den), (float)((ai * lr - nr * li) / den)}; cf[n] = c; COEF[g * 64 + n] = c; }
    }
    LBAR();
    for (int e = tid; e < 64 * 16; e += 512) { const int n = e >> 4; const float br = B_re[(size_t)g * 1024 + e], bi = B_im[(size_t)g * 1024 + e]; const f32x2 c = cf[n];
        bb[e] = (f32x2){c.x * br - c.y * bi, c.x * bi + c.y * br}; }
    LBAR();
    for (int e = tid; e < 32 * 256; e += 512) {
        const int d = e >> 8, p = (e >> 4) & 15, pp = e & 15;
        float acc = 0.f;
        for (int n = 0; n < 64; ++n) {
            const float cr = C_re[((size_t)g * 16 + p) * 64 + n], ci = C_im[((size_t)g * 16 + p) * 64 + n];
            const f32x2 P = pw[n * 33 + d], B = bb[n * 16 + pp];
            const float er = cr * P.x - ci * P.y, ei = cr * P.y + ci * P.x;
            acc += er * B.x - ei * B.y;
        }
        if (d == 0 && p == pp) acc += Dsk[g * 16 + p];
        KD[(size_t)g * 8192 + e] = acc;
    }
    LBAR();
}

__device__ __forceinline__ void p1_s5_tables(const Args& a, int gtid, int gthreads) {
    const float* B_re = (const float*)a.in[22]; const float* B_im = (const float*)a.in[23]; const float* C_re = (const float*)a.in[24]; const float* C_im = (const float*)a.in[25];
    const f32x2* PW = (const f32x2*)(a.ws + WS_PW); const f32x2* COEF = (const f32x2*)(a.ws + WS_COEF); const float* KD = (const float*)(a.ws + WS_KD);
    bf16_t* T = (bf16_t*)(a.ws + WS_S5T); bf16_t* W = (bf16_t*)(a.ws + WS_S5W);
    for (int q = gtid; q < 128 * 512 * 80; q += gthreads) {
        const int g = q / 40960, rem = q % 40960, row = rem / 80, ch = rem % 80, t = row >> 4, p = row & 15, col0 = ch * 8;
        float v[8];
        if (col0 < 512) { const int s = col0 >> 4, p0 = col0 & 15;
            if (s <= t) { const float* src = KD + (((size_t)g * 32 + (t - s)) * 16 + p) * 16 + p0; const f32x4 x = *(const f32x4*)src, y = *(const f32x4*)(src + 4);
                v[0] = x[0]; v[1] = x[1]; v[2] = x[2]; v[3] = x[3]; v[4] = y[0]; v[5] = y[1]; v[6] = y[2]; v[7] = y[3]; }
            else {
#pragma unroll
                for (int e = 0; e < 8; ++e) v[e] = 0.f; }
        } else { const int nn0 = col0 - 512, n0 = nn0 & 63, im = nn0 >> 6;
#pragma unroll
            for (int e = 0; e < 8; ++e) { const int n = n0 + e; const f32x2 P = ((const f32x2*)(a.ws + WS_PWT))[((size_t)g * 33 + t + 1) * 64 + n];
                const float cr = C_re[((size_t)g * 16 + p) * 64 + n], ci = C_im[((size_t)g * 16 + p) * 64 + n];
                v[e] = im ? -(cr * P.y + ci * P.x) : (cr * P.x - ci * P.y); }
        }
        u32x4 o; o.x = pk2(v[0], v[1]); o.y = pk2(v[2], v[3]); o.z = pk2(v[4], v[5]); o.w = pk2(v[6], v[7]);
        *(u32x4*)(T + ((size_t)g * 512 + row) * S5K + col0) = o;
    }
    for (int q = gtid; q < 128 * 256 * 64; q += gthreads) {
        const int g = q >> 14, rem = q & 16383, nn = rem >> 6, ch = rem & 63, col0 = ch * 8, s = col0 >> 4, p0 = col0 & 15;
        float v[8];
        if (nn >= 128) {
#pragma unroll
            for (int e = 0; e < 8; ++e) v[e] = 0.f;
        } else { const int n = nn & 63, im = nn >> 6; const f32x2 P = PW[((size_t)g * 64 + n) * 33 + 31 - s], c = COEF[g * 64 + n];
#pragma unroll
            for (int e = 0; e < 8; ++e) { const float br = B_re[((size_t)g * 64 + n) * 16 + p0 + e], bi = B_im[((size_t)g * 64 + n) * 16 + p0 + e];
                const float bbr = c.x * br - c.y * bi, bbi = c.x * bi + c.y * br;
                v[e] = im ? (P.x * bbi + P.y * bbr) : (P.x * bbr - P.y * bbi); }
        }
        u32x4 o; o.x = pk2(v[0], v[1]); o.y = pk2(v[2], v[3]); o.z = pk2(v[4], v[5]); o.w = pk2(v[6], v[7]);
        *(u32x4*)(W + ((size_t)g * 256 + nn) * 512 + col0) = o;
    }
}

struct RowPass {
    const float* xP; const float* xS;
    const bf16_t* outb;
    const float* gnA; const float* gate;
    const float* gnB; const float* sh; const float* sc;
    int hmode;
    const float* wgate; const float* bgate;
};
template <bool FIRST>
__device__ __forceinline__ void row_pass(const Args& a, const RowPass& R, LAS unsigned char* lds, int tid, int wave, int lane, int G, int bid) {
    float* Y = a.out; bf16_t* XB = (bf16_t*)(a.ws + WS_XB); bf16_t* H = (bf16_t*)(a.ws + WS_H); float* GT = (float*)(a.ws + WS_GT); float* HS = (float*)(a.ws + WS_HS);
    LAS float* vec = (LAS float*)(lds + SCR_OFF);
    LAS float* wgl = vec + 5 * 2048;
    const bool has_out = R.outb != nullptr, has_h = R.gnB != nullptr;
    if (R.hmode == 1) {
#pragma unroll 4
        for (int q = 0; q < 32; ++q) { const int e = tid + 512 * q; const int k = e >> 3, jj = e & 7; wgl[jj * 2048 + k] = R.wgate[(size_t)k * AIN + jj]; } }
    for (int blk = bid; blk < 256 + 16; blk += G) {
        const bool smp = blk >= 256; const int b16 = smp ? 8 + ((blk - 256) >> 1) : (blk >> 5);
        const int nrows = smp ? 1 : 16, m0 = smp ? MP + (blk - 256) * 8 + wave : blk * 128 + wave;
        struct Raw { u32x4 x[FIRST ? 8 : 4]; u32x4 o[4]; };
#define RP_LOAD(m_, rw) do { const int mm_ = (m_); \
            if constexpr (FIRST) { const float* xs_ = (mm_ < MP ? R.xP + (size_t)mm_ * D : R.xS + (size_t)(mm_ - MP) * D); \
                _Pragma("unroll") for (int j = 0; j < 4; ++j) { rw.x[2 * j] = *(const u32x4*)(xs_ + 8 * lane + 512 * j); rw.x[2 * j + 1] = *(const u32x4*)(xs_ + 8 * lane + 512 * j + 4); } } \
            else { const bf16_t* xr_ = XB + (size_t)mm_ * D; _Pragma("unroll") for (int j = 0; j < 4; ++j) rw.x[j] = __builtin_nontemporal_load((const u32x4*)(xr_ + 8 * lane + 512 * j)); } \
            if (has_out) { const bf16_t* or_ = R.outb + (size_t)mm_ * D; _Pragma("unroll") for (int j = 0; j < 4; ++j) rw.o[j] = *(const u32x4*)(or_ + 8 * lane + 512 * j); } \
            else { _Pragma("unroll") for (int j = 0; j < 4; ++j) rw.o[j] = (u32x4){0u, 0u, 0u, 0u}; } } while (0)
#define RP_PK4(j_) ((u32x4){pk2(v[4 * (j_)].x, v[4 * (j_)].y), pk2(v[4 * (j_) + 1].x, v[4 * (j_) + 1].y), pk2(v[4 * (j_) + 2].x, v[4 * (j_) + 2].y), pk2(v[4 * (j_) + 3].x, v[4 * (j_) + 3].y)})
        Raw ra, rb;
        RP_LOAD(m0, ra);
        LBAR();
        { const float* gp = has_out ? R.gate + (size_t)b16 * (6 * D) : nullptr; const float* scp = has_h ? R.sc + (size_t)b16 * (6 * D) : nullptr; const float* shp = has_h ? R.sh + (size_t)b16 * (6 * D) : nullptr;
        int tl_ = tid; asm volatile("" : "+v"(tl_));
#pragma unroll
        for (int q = 0; q < 4; ++q) { const unsigned e = (unsigned)tl_ + 512u * q;
            vec[0 * 2048 + e] = has_out ? gp[e] * R.gnA[e] : 0.f;
            vec[1 * 2048 + e] = has_h ? R.gnB[e] * (1.0f + scp[e]) : 0.f;
            vec[2 * 2048 + e] = has_h ? shp[e] : 0.f; } }
        LBAR();
        for (int i = 0; i < nrows; ++i) {
            const int m = m0 + 8 * i;
            asm volatile("" ::: "memory");
            if (i + 1 < nrows) RP_LOAD(m + 8, rb); else rb = ra;
            f32x2 v[16];
#pragma unroll
            for (int j = 0; j < 4; ++j) {
                if constexpr (FIRST) {
                    v[4 * j]     = (f32x2){__uint_as_float(ra.x[2 * j][0]), __uint_as_float(ra.x[2 * j][1])};     v[4 * j + 1] = (f32x2){__uint_as_float(ra.x[2 * j][2]), __uint_as_float(ra.x[2 * j][3])};
                    v[4 * j + 2] = (f32x2){__uint_as_float(ra.x[2 * j + 1][0]), __uint_as_float(ra.x[2 * j + 1][1])}; v[4 * j + 3] = (f32x2){__uint_as_float(ra.x[2 * j + 1][2]), __uint_as_float(ra.x[2 * j + 1][3])};
                } else {
#pragma unroll
                    for (int e = 0; e < 4; ++e) v[4 * j + e] = (f32x2){bflo(ra.x[j][e]), bfhi(ra.x[j][e])};
                }
            }
            if (has_out) {
                f32x2 o[16]; f32x2 s2 = (f32x2){0.f, 0.f};
#pragma unroll
                for (int j = 0; j < 4; ++j)
#pragma unroll
                    for (int e = 0; e < 4; ++e) o[4 * j + e] = (f32x2){bflo(ra.o[j][e]), bfhi(ra.o[j][e])};
#pragma unroll
                for (int k = 0; k < 16; ++k) s2 += o[k] * o[k];
                const float r1 = rsqrtf(wave_sum(s2.x + s2.y) * (1.0f / D) + EPS);
                const f32x2 r1v = (f32x2){r1, r1};
#pragma unroll
                for (int j = 0; j < 4; ++j)
#pragma unroll
                    for (int q = 0; q < 2; ++q) { const f32x4 g = *(const LAS f32x4*)(vec + 8 * lane + 512 * j + 4 * q);
                        v[4 * j + 2 * q]     += (o[4 * j + 2 * q] * r1v) * (f32x2){g[0], g[1]};
                        v[4 * j + 2 * q + 1] += (o[4 * j + 2 * q + 1] * r1v) * (f32x2){g[2], g[3]}; }
            }
            if (has_h) { bf16_t* xw_ = XB + (size_t)m * D;
#pragma unroll
                for (int j = 0; j < 4; ++j) __builtin_nontemporal_store(RP_PK4(j), (u32x4*)(xw_ + 8 * lane + 512 * j));
            } else {
#pragma unroll
                for (int j = 0; j < 4; ++j) { *(f32x4*)(Y + (size_t)m * D + 8 * lane + 512 * j) = (f32x4){v[4 * j].x, v[4 * j].y, v[4 * j + 1].x, v[4 * j + 1].y};
                    *(f32x4*)(Y + (size_t)m * D + 8 * lane + 512 * j + 4) = (f32x4){v[4 * j + 2].x, v[4 * j + 2].y, v[4 * j + 3].x, v[4 * j + 3].y}; }
            }
            if (has_h) {
                f32x2 s2 = (f32x2){0.f, 0.f};
#pragma unroll
                for (int k = 0; k < 16; ++k) s2 += v[k] * v[k];
                const float r2 = rsqrtf(wave_sum(s2.x + s2.y) * (1.0f / D) + EPS);
                const f32x2 r2v = (f32x2){r2, r2};
#pragma unroll
                for (int j = 0; j < 4; ++j)
#pragma unroll
                    for (int q = 0; q < 2; ++q) { const int cb = 8 * lane + 512 * j + 4 * q;
                        const f32x4 c1 = *(const LAS f32x4*)(vec + 1 * 2048 + cb), s0 = *(const LAS f32x4*)(vec + 2 * 2048 + cb);
                        v[4 * j + 2 * q]     = (v[4 * j + 2 * q] * r2v) * (f32x2){c1[0], c1[1]} + (f32x2){s0[0], s0[1]};
                        v[4 * j + 2 * q + 1] = (v[4 * j + 2 * q + 1] * r2v) * (f32x2){c1[2], c1[3]} + (f32x2){s0[2], s0[3]}; }
                if (R.hmode == 2 && smp) {
#pragma unroll
                    for (int j = 0; j < 4; ++j) { *(f32x4*)(HS + (size_t)(m - MP) * D + 8 * lane + 512 * j) = (f32x4){v[4 * j].x, v[4 * j].y, v[4 * j + 1].x, v[4 * j + 1].y};
                        *(f32x4*)(HS + (size_t)(m - MP) * D + 8 * lane + 512 * j + 4) = (f32x4){v[4 * j + 2].x, v[4 * j + 2].y, v[4 * j + 3].x, v[4 * j + 3].y}; }
                } else {
                    const int b = m >> 12, tp = m & 4095, c = tp >> 5, sq = tp & 31, inst = b * 128 + c;
                    bf16_t* hb = R.hmode == 2 ? H + (size_t)inst * S5K + sq * 16 : H + (size_t)m * D;
                    const unsigned loff = R.hmode == 2 ? (unsigned)(lane >> 1) * (unsigned)(1024 * S5K) + 8u * (unsigned)(lane & 1) : 8u * (unsigned)lane;
                    const size_t jstr = R.hmode == 2 ? (size_t)32 * 1024 * S5K : (size_t)512;
#pragma unroll
                    for (int j = 0; j < 4; ++j) *(u32x4*)(hb + j * jstr + loff) = RP_PK4(j);
                    if (R.hmode == 1) {
                        float ga[8];
#pragma unroll
                        for (int jj = 0; jj < 8; ++jj) { f32x2 sa = (f32x2){0.f, 0.f};
#pragma unroll
                            for (int j = 0; j < 4; ++j)
#pragma unroll
                                for (int q = 0; q < 2; ++q) { const f32x4 w = *(const LAS f32x4*)(wgl + jj * 2048 + 8 * lane + 512 * j + 4 * q);
                                    sa += v[4 * j + 2 * q] * (f32x2){w[0], w[1]}; sa += v[4 * j + 2 * q + 1] * (f32x2){w[2], w[3]}; }
                            ga[jj] = wave_sum(sa.x + sa.y); }
                        if (lane < 8) { float gsel = ga[0];
#pragma unroll
                            for (int jj = 1; jj < 8; ++jj) gsel = (lane == jj) ? ga[jj] : gsel;
                            gsel += R.bgate[lane];
                            if (lane >= 4) gsel = fminf(gsel, 0.f) - log1pf(__expf(-fabsf(gsel)));
                            GT[(size_t)m * 8 + lane] = gsel; }
                    }
                }
            }
            ra = rb;
        }
#undef RP_LOAD
#undef RP_PK4
    }
    LBAR();
}

__device__ __forceinline__ bf16x8 tr_read2(unsigned addr0, unsigned addr1) {
    bf16x4 lo, hi;
    asm volatile("ds_read_b64_tr_b16 %0, %2\n\tds_read_b64_tr_b16 %1, %3\n\ts_waitcnt lgkmcnt(0)" : "=&v"(lo), "=&v"(hi) : "v"(addr0), "v"(addr1) : "memory");
    return (bf16x8){lo[0], lo[1], lo[2], lo[3], hi[0], hi[1], hi[2], hi[3]};
}
__device__ __forceinline__ void tr_read4(unsigned a0, unsigned a1, unsigned a2, unsigned a3, bf16x8& x, bf16x8& y) {
    bf16x4 r0, r1, r2, r3;
    asm volatile("ds_read_b64_tr_b16 %0, %4\n\tds_read_b64_tr_b16 %1, %5\n\tds_read_b64_tr_b16 %2, %6\n\tds_read_b64_tr_b16 %3, %7\n\ts_waitcnt lgkmcnt(0)"
                 : "=&v"(r0), "=&v"(r1), "=&v"(r2), "=&v"(r3) : "v"(a0), "v"(a1), "v"(a2), "v"(a3) : "memory");
    x = (bf16x8){r0[0], r0[1], r0[2], r0[3], r1[0], r1[1], r1[2], r1[3]}; y = (bf16x8){r2[0], r2[1], r2[2], r2[3], r3[0], r3[1], r3[2], r3[3]};
}
template <int O0, int O1, int O2, int O3>
__device__ __forceinline__ void tr_read4o(unsigned base, bf16x8& x, bf16x8& y) {
    bf16x4 r0, r1, r2, r3;
    asm volatile("ds_read_b64_tr_b16 %0, %4 offset:%5\n\tds_read_b64_tr_b16 %1, %4 offset:%6\n\tds_read_b64_tr_b16 %2, %4 offset:%7\n\tds_read_b64_tr_b16 %3, %4 offset:%8\n\ts_waitcnt lgkmcnt(0)"
                 : "=&v"(r0), "=&v"(r1), "=&v"(r2), "=&v"(r3) : "v"(base), "i"(O0), "i"(O1), "i"(O2), "i"(O3) : "memory");
    x = (bf16x8){r0[0], r0[1], r0[2], r0[3], r1[0], r1[1], r1[2], r1[3]}; y = (bf16x8){r2[0], r2[1], r2[2], r2[3], r3[0], r3[1], r3[2], r3[3]};
}
struct GateVec { float bcs, av, Mv; float Mlast, mnew, mprev; };
template <int CTRL, int ROWMASK> __device__ __forceinline__ float dpp_take(float ident, float v) {
    return __builtin_bit_cast(float, __builtin_amdgcn_update_dpp(__builtin_bit_cast(int, ident), __builtin_bit_cast(int, v), CTRL, ROWMASK, 0xF, false));
}
__device__ __forceinline__ float scan_add64(float v) {
    v += dpp_take<0x111, 0xF>(0.f, v); v += dpp_take<0x112, 0xF>(0.f, v); v += dpp_take<0x114, 0xF>(0.f, v); v += dpp_take<0x118, 0xF>(0.f, v);
    v += dpp_take<0x142, 0xA>(0.f, v); v += dpp_take<0x143, 0xC>(0.f, v);
    return v;
}
__device__ __forceinline__ float scan_max64(float v) {
    const float ninf = -INFINITY;
    v = fmaxf(v, dpp_take<0x111, 0xF>(ninf, v)); v = fmaxf(v, dpp_take<0x112, 0xF>(ninf, v)); v = fmaxf(v, dpp_take<0x114, 0xF>(ninf, v)); v = fmaxf(v, dpp_take<0x118, 0xF>(ninf, v));
    v = fmaxf(v, dpp_take<0x142, 0xA>(ninf, v)); v = fmaxf(v, dpp_take<0x143, 0xC>(ninf, v));
    return v;
}
__device__ __forceinline__ GateVec gate_vectors(float li_v, float lf_v, float mprev, int TV, int lane) {
    GateVec g;
    const float bcs = scan_add64(lf_v);
    const float av = (lane < TV) ? li_v - bcs : -INFINITY;
    const float pm = scan_max64(av);
    const float Mv = fmaxf(mprev, pm);
    const float Mlast = __builtin_bit_cast(float, __builtin_amdgcn_readlane(__builtin_bit_cast(int, Mv), TV - 1));
    const float blast = __builtin_bit_cast(float, __builtin_amdgcn_readlane(__builtin_bit_cast(int, bcs), TV - 1));
    g.bcs = bcs; g.av = av; g.Mv = Mv; g.Mlast = Mlast; g.mnew = blast + Mlast; g.mprev = mprev;
    return g;
}
__device__ __forceinline__ void mlstm_scan(const Args& a, LAS unsigned char* lds, int j, int tid, int w, int lane, int G, int bid) {
    constexpr int QS = 0, KS = 33792, CTO = 67584, VS = 109824, VW = 121088, SP = 132352;
    constexpr int QSTR = 528, VSTR = 176, SSTR = 144;
    LAS unsigned char* L = lds + SCR_OFF;
    const unsigned Lb = (unsigned)(size_t)L;
    const bf16_t* Z = (const bf16_t*)(a.ws + WS_Z); const float* GT = (const float*)(a.ws + WS_GT);
    bf16_t* NUM = (bf16_t*)(a.ws + WS_OUTB); float* DEN = (float*)(a.ws + WS_DEN); float* MTb = (float*)(a.ws + WS_MT);
    const float* stC = (const float*)a.in[2]; const float* stN = (const float*)a.in[3]; const float* stM = (const float*)a.in[4];
    const int fr = lane & 15, fq = lane >> 4, qq = (lane & 15) >> 2, pp = lane & 3;
    const int tb = w >> 1, half = w & 1;
    for (int unit = bid; unit < 512; unit += G) {
        const bool smp = unit >= 256; const int uu = unit & 255, b = uu >> 5, h = (uu >> 3) & 3, dvs = uu & 7;
        const int row0 = smp ? MP + b * 16 : b * 4096, nch = smp ? 1 : 64, TV = smp ? 16 : 64;
        const int NT = dvs == 0 ? 5 : 4;
        const size_t sidx = (size_t)((j * 8 + b) * 4 + h);
        f32x4 cacc[5][2];
        float mprev = 0.f;
#pragma unroll
        for (int i = 0; i < 5; ++i)
#pragma unroll
            for (int jj = 0; jj < 2; ++jj) cacc[i][jj] = (f32x4){0.f, 0.f, 0.f, 0.f};
        if (smp) {
            const float* C0 = stC + sidx * 256 * 512;
#pragma unroll
            for (int i = 0; i < 4; ++i)
#pragma unroll
                for (int jj = 0; jj < 2; ++jj)
#pragma unroll
                    for (int r = 0; r < 4; ++r) cacc[i][jj][r] = C0[(size_t)(32 * w + 16 * jj + 4 * fq + r) * 512 + dvs * 64 + 16 * i + fr];
            if (NT == 5 && fr == 0) {
#pragma unroll
                for (int jj = 0; jj < 2; ++jj) cacc[4][jj] = *(const f32x4*)(stN + sidx * 256 + 32 * w + 16 * jj + 4 * fq);
            }
            mprev = stM[sidx];
        }
        u32x4 qreg[4], kreg[4], vreg; float li_v = 0.f, lf_v = 0.f, li_n = 0.f, lf_n = 0.f;
        const int srow = tid >> 3, sch = tid & 7;
#define ISSUE_LOADS(ch_) do { \
            const size_t grow_ = (size_t)(row0 + (ch_) * 64 + srow); \
            if (srow < TV) { \
                const bf16_t* zr = Z + grow_ * AINP; \
                _Pragma("unroll") for (int i = 0; i < 4; ++i) { qreg[i] = *(const u32x4*)(zr + h * 256 + (sch + 8 * i) * 8); kreg[i] = *(const u32x4*)(zr + 1024 + h * 256 + (sch + 8 * i) * 8); } \
                vreg = *(const u32x4*)(zr + 2048 + h * 512 + dvs * 64 + sch * 8); \
            } else { \
                _Pragma("unroll") for (int i = 0; i < 4; ++i) { qreg[i] = (u32x4){0u, 0u, 0u, 0u}; kreg[i] = (u32x4){0u, 0u, 0u, 0u}; } \
                vreg = (u32x4){0u, 0u, 0u, 0u}; \
            } \
        } while (0)
#define ISSUE_GATES(ch_, li_, lf_) do { if (lane < TV && (ch_) < nch) { const size_t gr_ = (size_t)(row0 + (ch_) * 64 + lane); li_ = GT[gr_ * 8 + h]; lf_ = GT[gr_ * 8 + 4 + h]; } else { li_ = 0.f; lf_ = 0.f; } } while (0)
        ISSUE_LOADS(0);
        ISSUE_GATES(0, li_v, lf_v); ISSUE_GATES(1, li_n, lf_n);
        GateVec gv = gate_vectors(li_v, lf_v, mprev, TV, lane);
#pragma unroll
        for (int i = 0; i < 5; ++i)
#pragma unroll
            for (int jj = 0; jj < 2; ++jj) { u32x2 wv; wv.x = pk2(cacc[i][jj][0], cacc[i][jj][1]); wv.y = pk2(cacc[i][jj][2], cacc[i][jj][3]);
                *(LAS u32x2*)(L + CTO + (16 * i + fr) * QSTR + (32 * w + 16 * jj + 4 * fq) * 2) = wv; }
        for (int ch = 0; ch < nch; ++ch) {
            LBAR();
            const float bcs = gv.bcs, av = gv.av, Mv = gv.Mv, wl = __expf(gv.av - gv.Mlast), decay = __expf(gv.mprev - gv.Mlast);
            if (dvs == 0 && w == 0 && lane < TV) MTb[(size_t)(row0 + ch * 64 + lane) * 4 + h] = bcs + Mv;
#pragma unroll
            for (int i = 0; i < 4; ++i) { *(LAS u32x4*)(L + QS + srow * QSTR + (sch + 8 * i) * 16) = qreg[i]; *(LAS u32x4*)(L + KS + srow * QSTR + (sch + 8 * i) * 16) = kreg[i]; }
            {
                const float wls = __shfl(wl, srow);
                *(LAS u32x4*)(L + VS + srow * VSTR + sch * 16) = vreg;
                u32x4 vw;
                vw.x = pk2(bflo(vreg.x) * wls, bfhi(vreg.x) * wls); vw.y = pk2(bflo(vreg.y) * wls, bfhi(vreg.y) * wls);
                vw.z = pk2(bflo(vreg.z) * wls, bfhi(vreg.z) * wls); vw.w = pk2(bflo(vreg.w) * wls, bfhi(vreg.w) * wls);
                *(LAS u32x4*)(L + VW + srow * VSTR + sch * 16) = vw;
                if (sch < 2) {
                    u32x4 one = (u32x4){0u, 0u, 0u, 0u}, wo = (u32x4){0u, 0u, 0u, 0u};
                    if (sch == 0 && srow < TV) { one.x = 0x3F80u; wo.x = pk2(wls, 0.f); }
                    *(LAS u32x4*)(L + VS + srow * VSTR + 128 + sch * 16) = one;
                    *(LAS u32x4*)(L + VW + srow * VSTR + 128 + sch * 16) = wo;
                }
            }
            if (ch + 1 < nch) ISSUE_LOADS(ch + 1);
            LBAR();
            const GateVec gn = gate_vectors(li_n, lf_n, gv.mnew, TV, lane);
            ISSUE_GATES(ch + 2, li_n, lf_n);
            bf16x8 qf[8];
#pragma unroll
            for (int kk = 0; kk < 8; ++kk) qf[kk] = *(const LAS bf16x8*)(L + QS + (16 * tb + fr) * QSTR + (32 * kk + 8 * fq) * 2);
            const int trow = 16 * tb + fr;
            const float Mt = __shfl(Mv, trow);
#pragma unroll
            for (int e = 0; e < 2; ++e) {
                const int sb = 2 * half + e;
                u32x2 wv = (u32x2){0u, 0u};
                if (sb <= tb) {
                    f32x4 s = (f32x4){0.f, 0.f, 0.f, 0.f};
#pragma unroll
                    for (int kk = 0; kk < 8; ++kk) { const bf16x8 kf = *(const LAS bf16x8*)(L + KS + (16 * sb + fr) * QSTR + (32 * kk + 8 * fq) * 2);
                        s = __builtin_amdgcn_mfma_f32_16x16x32_bf16(kf, qf[kk], s, 0, 0, 0); }
                    float pv[4];
#pragma unroll
                    for (int r = 0; r < 4; ++r) { const int sc = 16 * sb + 4 * fq + r; const float as = __shfl(av, sc); pv[r] = (sc <= trow) ? s[r] * __expf(as - Mt) : 0.f; }
                    wv.x = pk2(pv[0], pv[1]); wv.y = pk2(pv[2], pv[3]);
                }
                *(LAS u32x2*)(L + SP + trow * SSTR + (16 * sb + 4 * fq) * 2) = wv;
            }
            f32x4 nacc[3];
            const float iwt = __expf(gv.mprev - Mt);
#pragma unroll
            for (int q = 0; q < 3; ++q) {
                nacc[q] = (f32x4){0.f, 0.f, 0.f, 0.f};
                const int i = q < 2 ? 2 * half + q : 4;
                if (q < 2 || (half == 0 && NT == 5)) {
#pragma unroll
                    for (int kk = 0; kk < 8; ++kk) { const bf16x8 cfr = *(const LAS bf16x8*)(L + CTO + (16 * i + fr) * QSTR + (32 * kk + 8 * fq) * 2);
                        nacc[q] = __builtin_amdgcn_mfma_f32_16x16x32_bf16(cfr, qf[kk], nacc[q], 0, 0, 0); }
                    nacc[q] = nacc[q] * iwt;
                }
            }
            LBAR();
            const unsigned bvs = Lb + VS + (8 * fq + qq) * VSTR + (4 * pp) * 2;
            const unsigned bks = Lb + KS + (8 * fq + qq) * QSTR + (32 * w + 4 * pp) * 2;
            {
                const bf16x8 sf0 = *(const LAS bf16x8*)(L + SP + trow * SSTR + (8 * fq) * 2), sf1 = *(const LAS bf16x8*)(L + SP + trow * SSTR + (32 + 8 * fq) * 2);
                const unsigned bvh = bvs + 64 * half;
                const bool aug = (half == 0 && NT == 5);
                bf16x8 va0, va1, vb0, vb1, vc0, vc1;
#define V_READ(base_, off_, x_, y_) tr_read4o<(off_), (off_) + 4 * VSTR, (off_) + 32 * VSTR, (off_) + 36 * VSTR>(base_, x_, y_)
                V_READ(bvh, 0, va0, va1);
                nacc[0] = __builtin_amdgcn_mfma_f32_16x16x32_bf16(va0, sf0, nacc[0], 0, 0, 0); nacc[0] = __builtin_amdgcn_mfma_f32_16x16x32_bf16(va1, sf1, nacc[0], 0, 0, 0);
                V_READ(bvh, 32, vb0, vb1);
                nacc[1] = __builtin_amdgcn_mfma_f32_16x16x32_bf16(vb0, sf0, nacc[1], 0, 0, 0); nacc[1] = __builtin_amdgcn_mfma_f32_16x16x32_bf16(vb1, sf1, nacc[1], 0, 0, 0);
                if (aug) { V_READ(bvs, 128, vc0, vc1);
                    nacc[2] = __builtin_amdgcn_mfma_f32_16x16x32_bf16(vc0, sf0, nacc[2], 0, 0, 0); nacc[2] = __builtin_amdgcn_mfma_f32_16x16x32_bf16(vc1, sf1, nacc[2], 0, 0, 0); }
#undef V_READ
                bf16x8 kt[2][2], vwf[2], vwn[2];
                tr_read4o<0, 4 * QSTR, 32 * QSTR, 36 * QSTR>(bks, kt[0][0], kt[0][1]);
                tr_read4o<32, 32 + 4 * QSTR, 32 + 32 * QSTR, 32 + 36 * QSTR>(bks, kt[1][0], kt[1][1]);
#define W_READ(i_, x_, y_) tr_read4o<(VW - VS) + 32 * (i_), (VW - VS) + 32 * (i_) + 4 * VSTR, (VW - VS) + 32 * (i_) + 32 * VSTR, (VW - VS) + 32 * (i_) + 36 * VSTR>(bvs, x_, y_)
                W_READ(0, vwf[0], vwf[1]);
                if (trow < TV) {
                    const size_t grow = (size_t)(row0 + ch * 64 + trow);
#pragma unroll
                    for (int q = 0; q < 2; ++q) { u32x2 wv; wv.x = pk2(nacc[q][0], nacc[q][1]); wv.y = pk2(nacc[q][2], nacc[q][3]);
                        *(u32x2*)(NUM + grow * D + h * 512 + dvs * 64 + 16 * (2 * half + q) + 4 * fq) = wv; }
                    if (aug && fq == 0) DEN[grow * 4 + h] = nacc[2][0];
                }
#define E4_MMA(i_) do { _Pragma("unroll") for (int jj = 0; jj < 2; ++jj) { cacc[i_][jj] = cacc[i_][jj] * decay; \
                        _Pragma("unroll") for (int kk = 0; kk < 2; ++kk) cacc[i_][jj] = __builtin_amdgcn_mfma_f32_16x16x32_bf16(kt[jj][kk], vwf[kk], cacc[i_][jj], 0, 0, 0); } } while (0)
#define E4_PUT(i_) do { _Pragma("unroll") for (int jj = 0; jj < 2; ++jj) { u32x2 wv; wv.x = pk2(cacc[i_][jj][0], cacc[i_][jj][1]); wv.y = pk2(cacc[i_][jj][2], cacc[i_][jj][3]); \
                        *(LAS u32x2*)(L + CTO + (16 * (i_) + fr) * QSTR + (32 * w + 16 * jj + 4 * fq) * 2) = wv; } } while (0)
                E4_MMA(0); W_READ(1, vwn[0], vwn[1]); E4_PUT(0); vwf[0] = vwn[0]; vwf[1] = vwn[1];
                E4_MMA(1); W_READ(2, vwn[0], vwn[1]); E4_PUT(1); vwf[0] = vwn[0]; vwf[1] = vwn[1];
                E4_MMA(2); W_READ(3, vwn[0], vwn[1]); E4_PUT(2); vwf[0] = vwn[0]; vwf[1] = vwn[1];
                if (NT == 5) { E4_MMA(3); W_READ(4, vwn[0], vwn[1]); E4_PUT(3); vwf[0] = vwn[0]; vwf[1] = vwn[1]; E4_MMA(4); E4_PUT(4); }
                else { E4_MMA(3); E4_PUT(3); }
#undef E4_MMA
#undef E4_PUT
#undef W_READ
            }
            mprev = gv.mnew; gv = gn;
        }
        {
            float* oC = a.out + (smp ? O_SC : O_PC) + sidx * 256 * 512;
#pragma unroll
            for (int i = 0; i < 4; ++i)
#pragma unroll
                for (int jj = 0; jj < 2; ++jj)
#pragma unroll
                    for (int r = 0; r < 4; ++r) oC[(size_t)(32 * w + 16 * jj + 4 * fq + r) * 512 + dvs * 64 + 16 * i + fr] = cacc[i][jj][r];
            if (NT == 5 && fr == 0) {
                float* oN = a.out + (smp ? O_SN : O_PN) + sidx * 256;
#pragma unroll
                for (int jj = 0; jj < 2; ++jj) *(f32x4*)(oN + 32 * w + 16 * jj + 4 * fq) = cacc[4][jj];
            }
            if (dvs == 0 && tid == 0) a.out[(smp ? O_SM : O_PM) + sidx] = mprev;
        }
        LBAR();
    }
}

__device__ __forceinline__ void mlstm_headnorm(const Args& a, int j, int wave, int lane, int G, int bid) {
    const bf16_t* NUM = (const bf16_t*)(a.ws + WS_OUTB); const float* DEN = (const float*)(a.ws + WS_DEN); const float* MTb = (const float*)(a.ws + WS_MT);
    const bf16_t* Z = (const bf16_t*)(a.ws + WS_Z); bf16_t* YB = (bf16_t*)(a.ws + WS_YB); const float* gh = (const float*)a.in[15] + (size_t)j * D;
    const int hh = lane >> 4, c0 = hh * 512 + (lane & 15) * 8;
    float g[32];
#pragma unroll
    for (int q = 0; q < 8; ++q) { const f32x4 t = *(const f32x4*)(gh + c0 + 128 * (q >> 1) + 4 * (q & 1)); g[4 * q] = t[0]; g[4 * q + 1] = t[1]; g[4 * q + 2] = t[2]; g[4 * q + 3] = t[3]; }
    for (int tk = bid; tk < 256 + G; tk += G) {
        const bool smp = tk >= 256;
        const int gwi = (tk - 256) * 8 + wave;
        if (smp && gwi >= MS) continue;
        const int m0 = smp ? MP + gwi : tk * 128 + wave, nrows = smp ? 1 : 16;
        struct Raw { u32x4 n[4], o[4]; float den, mt; };
#define HN_LOAD(m_, rw) do { const bf16_t* np_ = NUM + (size_t)(m_) * D + c0; const bf16_t* op_ = Z + (size_t)(m_) * AINP + 4096 + c0; \
            _Pragma("unroll") for (int q = 0; q < 4; ++q) { rw.n[q] = *(const u32x4*)(np_ + 128 * q); rw.o[q] = *(const u32x4*)(op_ + 128 * q); } \
            rw.den = DEN[(size_t)(m_) * 4 + hh]; rw.mt = MTb[(size_t)(m_) * 4 + hh]; } while (0)
        Raw ra, rb;
        HN_LOAD(m0, ra);
        for (int i = 0; i < nrows; ++i) {
            const int m = m0 + 8 * i;
            if (i + 1 < nrows) HN_LOAD(m + 8, rb); else rb = ra;
            const float inv = 1.0f / fmaxf(fabsf(ra.den), __expf(-ra.mt));
            float hv[32]; float ss = 0.f;
#pragma unroll
            for (int q = 0; q < 4; ++q)
#pragma unroll
                for (int e = 0; e < 4; ++e) { hv[8 * q + 2 * e] = bflo(ra.n[q][e]) * inv; hv[8 * q + 2 * e + 1] = bfhi(ra.n[q][e]) * inv; }
#pragma unroll
            for (int k = 0; k < 32; ++k) ss += hv[k] * hv[k];
            ss += __shfl_xor(ss, 1); ss += __shfl_xor(ss, 2); ss += __shfl_xor(ss, 4); ss += __shfl_xor(ss, 8);
            const float rs = rsqrtf(ss * (1.0f / 512.0f) + EPS);
#pragma unroll
            for (int q = 0; q < 4; ++q) {
                float r[8];
#pragma unroll
                for (int e = 0; e < 4; ++e) { r[2 * e] = hv[8 * q + 2 * e] * rs * g[8 * q + 2 * e] * fsig(bflo(ra.o[q][e])); r[2 * e + 1] = hv[8 * q + 2 * e + 1] * rs * g[8 * q + 2 * e + 1] * fsig(bfhi(ra.o[q][e])); }
                u32x4 o; o.x = pk2(r[0], r[1]); o.y = pk2(r[2], r[3]); o.z = pk2(r[4], r[5]); o.w = pk2(r[6], r[7]);
                *(u32x4*)(YB + (size_t)m * D + c0 + 128 * q) = o; }
            ra = rb;
        }
#undef HN_LOAD
    }
}

__device__ __forceinline__ void conv_pass(const Args& a, LAS unsigned char* lds, int tid, int wave, int lane, int G, int bid) {
    const bf16_t* Z = (const bf16_t*)(a.ws + WS_Z); bf16_t* YB = (bf16_t*)(a.ws + WS_YB); const float* wc = (const float*)a.in[18]; const float* stc = (const float*)a.in[5];
    LAS float* wl = (LAS float*)(lds + SCR_OFF);
    for (int e = tid; e < 3 * 2048; e += 512) { const int c = e / 3, k = e - 3 * c; wl[k * 2048 + c] = wc[e]; }
    LBAR();
    for (int tk = bid; tk < 256 + G; tk += G) {
        const bool smp = tk >= 256;
        const int gwi = (tk - 256) * 8 + wave;
        if (smp && gwi >= MS) continue;
        const int m0 = smp ? MP + gwi : tk * 128 + wave * 16, nrows = smp ? 1 : 16;
        const int bb = smp ? gwi >> 4 : m0 >> 12, t0 = smp ? gwi & 15 : m0 & 4095, Lq = smp ? 16 : 4096;
        u32x4 z1[4], z2[4];
#pragma unroll
        for (int j = 0; j < 4; ++j) {
            const float* p1 = stc + ((size_t)bb * 2 + 1) * D + 8 * lane + 512 * j; const float* p0 = stc + ((size_t)bb * 2 + 0) * D + 8 * lane + 512 * j;
            if (t0 >= 1) z1[j] = *(const u32x4*)(Z + (size_t)(m0 - 1) * 4096 + 8 * lane + 512 * j);
            else if (smp) z1[j] = (u32x4){pk2(p1[0], p1[1]), pk2(p1[2], p1[3]), pk2(p1[4], p1[5]), pk2(p1[6], p1[7])};
            else z1[j] = (u32x4){0u, 0u, 0u, 0u};
            if (t0 >= 2) z2[j] = *(const u32x4*)(Z + (size_t)(m0 - 2) * 4096 + 8 * lane + 512 * j);
            else if (smp && t0 == 1) z2[j] = (u32x4){pk2(p1[0], p1[1]), pk2(p1[2], p1[3]), pk2(p1[4], p1[5]), pk2(p1[6], p1[7])};
            else if (smp) z2[j] = (u32x4){pk2(p0[0], p0[1]), pk2(p0[2], p0[3]), pk2(p0[4], p0[5]), pk2(p0[6], p0[7])};
            else z2[j] = (u32x4){0u, 0u, 0u, 0u};
        }
        struct Raw { u32x4 z[4], g[4]; };
#define CV_LOAD(m_, rw) do { const bf16_t* zp_ = Z + (size_t)(m_) * 4096 + 8 * lane; _Pragma("unroll") for (int j = 0; j < 4; ++j) { rw.z[j] = *(const u32x4*)(zp_ + 512 * j); rw.g[j] = *(const u32x4*)(zp_ + 2048 + 512 * j); } } while (0)
        Raw ra, rb;
        CV_LOAD(m0, ra);
        for (int i = 0; i < nrows; ++i) {
            const int m = m0 + i, t = t0 + i;
            asm volatile("" ::: "memory");
            if (i + 1 < nrows) CV_LOAD(m + 1, rb); else rb = ra;
#pragma unroll
            for (int j = 0; j < 4; ++j) {
                float y[8];
#pragma unroll
                for (int q = 0; q < 2; ++q) {
                    const f32x4 k0 = *(const LAS f32x4*)(wl + 8 * lane + 512 * j + 4 * q), k1 = *(const LAS f32x4*)(wl + 2048 + 8 * lane + 512 * j + 4 * q), k2 = *(const LAS f32x4*)(wl + 4096 + 8 * lane + 512 * j + 4 * q);
#pragma unroll
                    for (int e = 0; e < 2; ++e) { const unsigned w0 = ra.z[j][2 * q + e], w1 = z1[j][2 * q + e], w2 = z2[j][2 * q + e], wg = ra.g[j][2 * q + e];
                        y[4 * q + 2 * e] = bflo(wg) * (bflo(w2) * k0[2 * e] + bflo(w1) * k1[2 * e] + bflo(w0) * k2[2 * e]);
                        y[4 * q + 2 * e + 1] = bfhi(wg) * (bfhi(w2) * k0[2 * e + 1] + bfhi(w1) * k1[2 * e + 1] + bfhi(w0) * k2[2 * e + 1]); }
                }
                u32x4 o; o.x = pk2(y[0], y[1]); o.y = pk2(y[2], y[3]); o.z = pk2(y[4], y[5]); o.w = pk2(y[6], y[7]);
                *(u32x4*)(YB + (size_t)m * D + 8 * lane + 512 * j) = o;
                if (t >= Lq - 2) { float* op = a.out + (smp ? O_SCONV : O_PCONV) + ((size_t)bb * 2 + (t - (Lq - 2))) * D + 8 * lane + 512 * j;
                    *(f32x4*)op = (f32x4){bflo(ra.z[j].x), bfhi(ra.z[j].x), bflo(ra.z[j].y), bfhi(ra.z[j].y)}; *(f32x4*)(op + 4) = (f32x4){bflo(ra.z[j].z), bfhi(ra.z[j].z), bflo(ra.z[j].w), bfhi(ra.z[j].w)}; }
                z2[j] = z1[j]; z1[j] = ra.z[j];
            }
            ra = rb;
        }
#undef CV_LOAD
    }
    LBAR();
}

__device__ __forceinline__ void s5_scan(const Args& a, int it, int tid) {
    const int gid = it * 512 + tid, n = gid & 63, g = (gid >> 6) & 127, b = gid >> 13;
    const f32x2* PW = (const f32x2*)(a.ws + WS_PW); const float* XL = (const float*)(a.ws + WS_Z); bf16_t* HG = (bf16_t*)(a.ws + WS_H);
    const f32x2 A32 = ((const f32x2*)(a.ws + WS_PWT))[((size_t)g * 33 + 32) * 64 + n];
    float xr = 0.f, xi = 0.f;
#pragma unroll 8
    for (int c = 0; c < 128; ++c) {
        const size_t inst = (size_t)g * 1024 + b * 128 + c;
        HG[inst * S5K + 512 + n] = (bf16_t)(pk2(xr, 0.f) & 0xffffu); HG[inst * S5K + 576 + n] = (bf16_t)(pk2(xi, 0.f) & 0xffffu);
        const float lr = XL[inst * 128 + n], li = XL[inst * 128 + 64 + n];
        const float nr = A32.x * xr - A32.y * xi + lr, ni = A32.x * xi + A32.y * xr + li;
        xr = nr; xi = ni;
    }
    a.out[O_PRE + ((size_t)b * 128 + g) * 64 + n] = xr; a.out[O_PIM + ((size_t)b * 128 + g) * 64 + n] = xi;
}
__device__ __forceinline__ void s5_sample(const Args& a, LAS unsigned char* lds, int it, int wave, int lane) {
    const int wv = it * 8 + wave, b = wv >> 7, g = wv & 127, n = lane;
    const f32x2* PW = (const f32x2*)(a.ws + WS_PW); const f32x2* COEF = (const f32x2*)(a.ws + WS_COEF); const float* HS = (const float*)(a.ws + WS_HS); bf16_t* YB = (bf16_t*)(a.ws + WS_YB2);
    const float* B_re = (const float*)a.in[22]; const float* B_im = (const float*)a.in[23]; const float* C_re = (const float*)a.in[24]; const float* C_im = (const float*)a.in[25]; const float* Dsk = (const float*)a.in[26];
    LAS float* U = (LAS float*)(lds + SCR_OFF + wave * 9216);
    LAS float* Xre = U + 256; LAS float* Xim = U + 256 + 1024;
    *(LAS f32x4*)(U + (lane >> 2) * 16 + (lane & 3) * 4) = *(const f32x4*)(HS + (size_t)(b * 16 + (lane >> 2)) * D + g * 16 + (lane & 3) * 4);
    const f32x2 Ab = ((const f32x2*)(a.ws + WS_PWT))[((size_t)g * 33 + 1) * 64 + n], cf = COEF[g * 64 + n];
    float bbr[16], bbi[16];
#pragma unroll
    for (int q = 0; q < 4; ++q) { const f32x4 br4 = *(const f32x4*)(B_re + ((size_t)g * 64 + n) * 16 + 4 * q), bi4 = *(const f32x4*)(B_im + ((size_t)g * 64 + n) * 16 + 4 * q);
#pragma unroll
        for (int e = 0; e < 4; ++e) { bbr[4 * q + e] = cf.x * br4[e] - cf.y * bi4[e]; bbi[4 * q + e] = cf.x * bi4[e] + cf.y * br4[e]; } }
    float xr = ((const float*)a.in[6])[((size_t)b * 128 + g) * 64 + n], xi = ((const float*)a.in[7])[((size_t)b * 128 + g) * 64 + n];
    LDS_WAIT(); asm volatile("" ::: "memory");
#pragma unroll 2
    for (int t = 0; t < 16; ++t) {
        float br = 0.f, bi = 0.f;
#pragma unroll
        for (int q = 0; q < 4; ++q) { const f32x4 u4 = *(const LAS f32x4*)(U + t * 16 + 4 * q);
#pragma unroll
            for (int e = 0; e < 4; ++e) { br += bbr[4 * q + e] * u4[e]; bi += bbi[4 * q + e] * u4[e]; } }
        const float nr = Ab.x * xr - Ab.y * xi + br, ni = Ab.x * xi + Ab.y * xr + bi; xr = nr; xi = ni;
        Xre[t * 64 + n] = xr; Xim[t * 64 + n] = xi;
    }
    a.out[O_SRE + ((size_t)b * 128 + g) * 64 + n] = xr; a.out[O_SIM + ((size_t)b * 128 + g) * 64 + n] = xi;
    LDS_WAIT(); asm volatile("" ::: "memory");
    const int p = lane & 15, tq = lane >> 4;
    float acc[4] = {0.f, 0.f, 0.f, 0.f};
#pragma unroll 2
    for (int q = 0; q < 16; ++q) {
        const f32x4 c4 = *(const f32x4*)(C_re + ((size_t)g * 16 + p) * 64 + 4 * q), d4 = *(const f32x4*)(C_im + ((size_t)g * 16 + p) * 64 + 4 * q);
#pragma unroll
        for (int tt = 0; tt < 4; ++tt) { const f32x4 xr4 = *(const LAS f32x4*)(Xre + (4 * tq + tt) * 64 + 4 * q), xi4 = *(const LAS f32x4*)(Xim + (4 * tq + tt) * 64 + 4 * q);
            acc[tt] += (c4[0] * xr4[0] - d4[0] * xi4[0]) + (c4[1] * xr4[1] - d4[1] * xi4[1]) + (c4[2] * xr4[2] - d4[2] * xi4[2]) + (c4[3] * xr4[3] - d4[3] * xi4[3]); }
    }
    const float dsk = Dsk[g * 16 + p];
#pragma unroll
    for (int tt = 0; tt < 4; ++tt) { const int t = 4 * tq + tt; const float y = acc[tt] + dsk * U[t * 16 + p];
        const float uu = 0.7978845608f * (y + 0.044715f * y * y * y); const float gl = y * fsig(2.0f * uu);
        YB[(size_t)(MP + b * 16 + t) * D + g * 16 + p] = (bf16_t)(pk2(gl, 0.f) & 0xffffu); }
    LDS_WAIT(); asm volatile("" ::: "memory");
}

#define XR(b_, g_) ((((g_) & 7) == 0) ? ((b_) & 7) * ((g_) >> 3) + ((b_) >> 3) : (b_))
#define PH_BEGIN if (ph >= lo && ph < hi) { Args args = args0; int tid = tid0, bid = bid0, G = G0; unsigned zlo_ = 0; asm volatile("" : "+v"(tid)); asm volatile("" : "+s"(zlo_)); asm volatile("" : "+s"(bid)); asm volatile("" : "+s"(G)); \
    bid = __builtin_amdgcn_readfirstlane(bid); G = __builtin_amdgcn_readfirstlane(G); const size_t zoff_ = (size_t)(unsigned)__builtin_amdgcn_readfirstlane((int)zlo_); args.ws = args0.ws + zoff_; args.out = args0.out + zoff_; \
    const int lane = tid & 63, wave = __builtin_amdgcn_readfirstlane(tid >> 6); (void)lane; (void)wave; \
    const float* MOD = (const float*)(args.ws + WS_MOD); const float* gnorm = (const float*)args.in[12]; \
    bf16_t* H = (bf16_t*)(args.ws + WS_H); bf16_t* Zb = (bf16_t*)(args.ws + WS_Z); bf16_t* OUTB = (bf16_t*)(args.ws + WS_OUTB); bf16_t* YB = (bf16_t*)(args.ws + WS_YB); \
    (void)MOD; (void)gnorm; (void)H; (void)Zb; (void)OUTB; (void)YB;
#define PH_END   if (ph + 1 < hi) xcd_barrier(bar); } ++ph;


template <int layer>
__device__ __forceinline__ void layer_phases(const Args& args0, LAS unsigned char* lds, const int tid0, const int bid0, const int G0, const int lo, const int hi, const XcdBarrier& bar) {
    constexpr int kind = layer % 3, jm = layer / 3;
    int ph = layer == 0 ? 2 : (layer == 1 ? 10 : (layer == 2 ? 17 : 25));
#define modL (MOD + (size_t)layer * 16 * 6 * D)
#define gnL (gnorm + (size_t)layer * 4 * D)
#define GEMM_CALL(LDA_, LDB_, K_, EPI_, SCHED_) pg8::gemm_phase<LDA_, LDB_, K_, EPI_, SCHED_, PG8_ALIGN, PG8_SP2>(lds + SCR_OFF, g, S, E, tid)
        if constexpr (kind == 0) {
            PH_BEGIN
                const bf16_t* W = (const bf16_t*)(args.ws + WS_WA_IN) + (size_t)jm * AINP * D;
                pg8::Gemm g{H, W}; typedef pg8::StaticOrder<128, 24> SO; SO S{G, bid}; typedef pg8::EpiGen<AINP, 0, 0, 0> EP; EP E{Zb};
                GEMM_CALL(D, D, D, EP, SO);
                pg8::skinny2<D, D, D>(H, W, Zb, AINP, 0, 192, 0, 0, 0, MP, lds + SCR_OFF, wave, lane, XR(bid, G), G);
            PH_END
            PH_BEGIN
                mlstm_scan(args, lds, jm, tid, wave, lane, G, XR(bid, G));
            PH_END
            PH_BEGIN
                mlstm_headnorm(args, jm, wave, lane, G, bid);
            PH_END
            PH_BEGIN
                const bf16_t* W = (const bf16_t*)(args.ws + WS_WA_OUT) + (size_t)jm * D * D;
                pg8::Gemm g{YB, W}; typedef pg8::StaticOrder<128, 8> SO; SO S{G, bid}; typedef pg8::EpiGen<D, 0, 0, 0> EP; EP E{OUTB};
                GEMM_CALL(D, D, D, EP, SO);
                pg8::skinny2<D, D, D>(YB, W, OUTB, D, 0, 64, 0, 0, 0, MP, lds + SCR_OFF, wave, lane, XR(bid, G), G);
            PH_END
        } else if constexpr (kind == 1) {
            PH_BEGIN
                const bf16_t* W = (const bf16_t*)(args.ws + WS_WB_IN);
                pg8::Gemm g{H, W}; typedef pg8::StaticOrder<128, 24> SO; SO S{G, bid}; typedef pg8::EpiGen<4096, 16, 0, -2048> EP; EP E{Zb};
                GEMM_CALL(D, D, D, EP, SO);
                pg8::skinny2<D, D, D>(H, W, Zb, 4096, 64, 64, 0, 4096, 2048, MP, lds + SCR_OFF, wave, lane, XR(bid, G), G);
            PH_END
            PH_BEGIN
                conv_pass(args, lds, tid, wave, lane, G, bid);
            PH_END
            PH_BEGIN
                const bf16_t* W = (const bf16_t*)(args.ws + WS_WB_OUT);
                pg8::Gemm g{YB, W}; typedef pg8::StaticOrder<128, 8> SO; SO S{G, bid}; typedef pg8::EpiGen<D, 0, 0, 0> EP; EP E{OUTB};
                GEMM_CALL(D, D, D, EP, SO);
                pg8::skinny2<D, D, D>(YB, W, OUTB, D, 0, 64, 0, 0, 0, MP, lds + SCR_OFF, wave, lane, XR(bid, G), G);
            PH_END
        } else {
            PH_BEGIN
                pg8::Gemm g{H, (const bf16_t*)(args.ws + WS_S5W)}; pg8::S5aOrder S{G, XR(bid, G)};
                pg8::EpiS5a E{(float*)(args.ws + WS_Z)};
                GEMM_CALL(S5K, 512, 512, pg8::EpiS5a, pg8::S5aOrder);
            PH_END
            PH_BEGIN
                for (int it = bid; it < 256; it += G) { if (it < 128) s5_scan(args, it, tid); else s5_sample(args, lds, it - 128, wave, lane); }
            PH_END
            PH_BEGIN
                pg8::Gemm g{H, (const bf16_t*)(args.ws + WS_S5T)}; pg8::S5cOrder S{G, XR(bid, G)};
                pg8::EpiS5c E{(bf16_t*)(args.ws + WS_YB2)};
                GEMM_CALL(S5K, S5K, S5K, pg8::EpiS5c, pg8::S5cOrder);
            PH_END
            PH_BEGIN
                const bf16_t* W = (const bf16_t*)(args.ws + WS_WC_OUT);
                const bf16_t* Y2 = (const bf16_t*)(args.ws + WS_YB2);
                pg8::Gemm g{Y2, W}; typedef pg8::StaticOrder<128, 16> SO; SO S{G, bid}; typedef pg8::EpiGen<D, 16, 2, 0> EP; EP E{OUTB};
                GEMM_CALL(D, D, D, EP, SO);
                pg8::skinny2<D, D, D>(Y2, W, OUTB, D, 64, 0, 2, 0, 0, MP, lds + SCR_OFF, wave, lane, XR(bid, G), G);
            PH_END
        }
        PH_BEGIN
            RowPass R{nullptr, nullptr, OUTB, gnL + 1 * D, modL + 2 * D, gnL + 2 * D, modL + 3 * D, modL + 4 * D, 0, nullptr, nullptr};
            row_pass<false>(args, R, lds, tid, wave, lane, G, bid);
        PH_END
        PH_BEGIN
            const bf16_t* W = (const bf16_t*)(args.ws + WS_WGU) + (size_t)layer * 2 * DFF * D;
            pg8::Gemm g{H, W}; typedef pg8::StaticOrder<128, 44> SO; SO S{G, bid}; typedef pg8::EpiGen<DFF, 44, 1, 0> EP; EP E{Zb};
            GEMM_CALL(D, D, D, EP, SO);
            pg8::skinny2<D, D, D>(H, W, Zb, DFF, 176, 0, 1, 0, 0, MP, lds + SCR_OFF, wave, lane, XR(bid, G), G);
        PH_END
        PH_BEGIN
            const bf16_t* W = (const bf16_t*)(args.ws + WS_WDN) + (size_t)layer * D * DFF;
            pg8::Gemm g{Zb, W}; typedef pg8::StaticOrder<128, 8> SO; SO S{G, bid}; typedef pg8::EpiGen<D, 0, 0, 0> EP; EP E{OUTB};
            GEMM_CALL(DFF, DFF, DFF, EP, SO);
            pg8::skinny2<DFF, DFF, DFF>(Zb, W, OUTB, D, 0, 64, 0, 0, 0, MP, lds + SCR_OFF, wave, lane, XR(bid, G), G);
        PH_END
        PH_BEGIN
            const int nl = layer + 1, nk = nl % 3;
            const float* modN = MOD + (size_t)nl * 16 * 6 * D;
            RowPass R{nullptr, nullptr, OUTB, gnL + 3 * D, modL + 5 * D, nl < DEPTH ? gnorm + (size_t)nl * 4 * D : nullptr, modN + 0 * D, modN + 1 * D,
                      nk == 0 ? 1 : (nk == 2 ? 2 : 0), (const float*)args.in[13] + (size_t)(nl / 3) * D * AIN + AINP, (const float*)args.in[14] + (nl / 3) * 8};
            row_pass<false>(args, R, lds, tid, wave, lane, G, bid);
        PH_END
    }
__global__ void __launch_bounds__(512, 2) mk_fwd(Args args0) {
    extern __shared__ __attribute__((aligned(16))) unsigned char lds_raw[];
    LAS unsigned char* lds = (LAS unsigned char*)lds_raw;
    const int tid0 = threadIdx.x, bid0 = blockIdx.x, G0 = gridDim.x;
    if (tid0 < 64) ((LAS unsigned*)(lds + LCTL_OFF))[tid0] = 0u;
    __syncthreads();
    unsigned* ctl = (unsigned*)(args0.ws + WS_CTL);
    XcdBarrier bar = xcd_barrier_post(ctl + 4096 + args0.li * XCD_BAR_WORDS, (volatile LAS unsigned*)(lds + LCTL_OFF));
    int ph = 0;
    const int lo = args0.ph_lo, hi = args0.ph_hi;
    PH_BEGIN
        if (bid < 64) { p0_s5_group(args, lds, bid, tid); p0_s5_group(args, lds, bid + 64, tid); }
        for (int task = bid - 64; task >= 0 && task < 192; task += G) p0_mod_task(args, lds, task, tid, wave, lane);
        p0_weights(args, lds, wave, lane, G, bid);
    PH_END
    PH_BEGIN
        RowPass R{(const float*)args.in[0], (const float*)args.in[1], nullptr, nullptr, nullptr, gnorm, MOD + 0 * D, MOD + 1 * D, 1, (const float*)args.in[13] + AINP, (const float*)args.in[14]};
        row_pass<true>(args, R, lds, tid, wave, lane, G, bid);
        p1_s5_tables(args, bid * 512 + tid, G * 512);
    PH_END

    layer_phases<0>(args0, lds, tid0, bid0, G0, lo, hi, bar);
    layer_phases<1>(args0, lds, tid0, bid0, G0, lo, hi, bar);
    layer_phases<2>(args0, lds, tid0, bid0, G0, lo, hi, bar);
    layer_phases<3>(args0, lds, tid0, bid0, G0, lo, hi, bar);
#undef GEMM_CALL
#undef PH_BEGIN
#undef PH_END
#undef modL
#undef gnL
}

extern "C" void kernel_launch(void* const* d_in, const int* in_sizes, int n_in, void* d_out, int out_size, void* d_ws, size_t ws_size, hipStream_t stream) {
    static int grid = 0;
    if (grid == 0) {
        if (n_in != 32 || (size_t)out_size != OUT_TOTAL || ws_size < WS_END) {
            fprintf(stderr, "kernel_launch: unexpected shapes: n_in %d out %d (want %zu) ws %zu (want >= %zu); nothing launched\n", n_in, out_size, (size_t)OUT_TOTAL, ws_size, (size_t)WS_END); grid = -1; return; }
        int dev = 0, cus = 0, per_cu = 0;
        if (hipGetDevice(&dev) != hipSuccess || hipDeviceGetAttribute(&cus, hipDeviceAttributeMultiprocessorCount, dev) != hipSuccess) { grid = -1; return; }
        if (hipFuncSetAttribute((const void*)mk_fwd, hipFuncAttributeMaxDynamicSharedMemorySize, LDS_BYTES) != hipSuccess) { fprintf(stderr, "kernel_launch: hipFuncSetAttribute failed\n"); grid = -1; return; }
        if (hipOccupancyMaxActiveBlocksPerMultiprocessor(&per_cu, (const void*)mk_fwd, 512, LDS_BYTES) != hipSuccess || per_cu < 1) { fprintf(stderr, "kernel_launch: occupancy query says %d\n", per_cu); }
        (void)hipGetLastError();
        grid = cus;
    }
    if (grid < 0) return;
    (void)hipMemsetAsync((char*)d_ws + WS_CTL, 0, CTL_ZERO_BYTES, stream);
    Args a{};
    for (int i = 0; i < 32; ++i) a.in[i] = d_in[i];
    a.out = (float*)d_out; a.ws = (unsigned char*)d_ws;
    constexpr int NPH = 2 + 8 + 7 + 8 + 8;
#ifdef DBG_STOP
    for (int p = 0; p < DBG_STOP; ++p) { a.ph_lo = p; a.ph_hi = p + 1; a.li = 0; hipLaunchKernelGGL(mk_fwd, dim3(grid), dim3(512), LDS_BYTES, stream, a); }
    (void)hipMemcpyAsync((char*)d_out, (char*)d_ws + (size_t)DBG_DUMP_OFF, (size_t)DBG_DUMP_BYTES, hipMemcpyDeviceToDevice, stream);
    return;
#endif
#if MK_N_LAUNCHES == 1
    a.ph_lo = 0; a.ph_hi = NPH; a.li = 0;
    hipLaunchKernelGGL(mk_fwd, dim3(grid), dim3(512), LDS_BYTES, stream, a);
#else
#ifndef DBG_REPMASK
#define DBG_REPMASK 0ull
#endif
    for (int p = 0; p < NPH; ++p) { const int nrep = ((DBG_REPMASK >> p) & 1ull) ? 2 : 1;
        for (int r = 0; r < nrep; ++r) { a.ph_lo = p; a.ph_hi = p + 1; a.li = 0; hipLaunchKernelGGL(mk_fwd, dim3(grid), dim3(512), LDS_BYTES, stream, a); } }
#endif
    const hipError_t le = hipPeekAtLastError();
    if (le != hipSuccess) fprintf(stderr, "kernel_launch: launch failed: %s\n", hipGetErrorName(le));
}
```
